# Optimizing an MI355X kernel written in HIP

```python
import jax, jax.numpy as jnp
from jax import lax
import numpy as np

D_MODEL = 1024
BATCH = 8
SEQ = 4096
DEPTH = 2

N_BRANCH = 4
MIX_W = 256
SGU_GROUPS = 4
SGU_CHUNK = 128
N_Q_HEADS = 4
N_KV_HEADS = 2
HEAD_DIM = 64
WINDOW = 128
ROT_DIM = HEAD_DIM // 4
ROPE_THETA = 500000.0
SHORT_CONV = 3
CONFORMER_CONV = 31
N_GROUPS = 4
EXPERTS_PER_GROUP = 4
N_EXPERTS = N_GROUPS * EXPERTS_PER_GROUP
TOP_K = 2
D_EXPERT = 256
EPS = 1e-6

IN_WIDTHS = (MIX_W, MIX_W,
             N_Q_HEADS * HEAD_DIM, N_KV_HEADS * HEAD_DIM, N_KV_HEADS * HEAD_DIM,
             MIX_W, MIX_W, MIX_W,
             MIX_W, MIX_W)
D_IN = sum(IN_WIDTHS)

kernel_name = 'hybrid_gated_branches_hier_moe'


def rmsnorm(x, g):
    xf = x.astype(jnp.float32)
    y = xf * lax.rsqrt(jnp.mean(xf * xf, axis=-1, keepdims=True) + EPS)
    return (y * g.astype(jnp.float32)).astype(x.dtype)


def layernorm(x, g, b):
    xf = x.astype(jnp.float32)
    mu = jnp.mean(xf, axis=-1, keepdims=True)
    xc = xf - mu
    var = jnp.mean(xc * xc, axis=-1, keepdims=True)
    y = xc * lax.rsqrt(var + EPS) * g.astype(jnp.float32) + b.astype(jnp.float32)
    return y.astype(x.dtype)


def causal_dwconv(x, w):
    k, c = w.shape
    return lax.conv_general_dilated(x, w[:, None, :], window_strides=(1,), padding=[(k - 1, 0)],
                                    dimension_numbers=('NWC', 'WIO', 'NWC'), feature_group_count=c)


def split_cols(p):
    outs, start = [], 0
    for w in IN_WIDTHS:
        outs.append(p[..., start:start + w])
        start += w
    return outs


def rope_tables(positions):
    inv = ROPE_THETA ** (-jnp.arange(0, ROT_DIM, 2, dtype=jnp.float32) / ROT_DIM)
    ang = positions.astype(jnp.float32)[..., None] * inv
    return jnp.cos(ang)[:, :, None, :], jnp.sin(ang)[:, :, None, :]


def apply_partial_rope(x, cos, sin):
    half = ROT_DIM // 2
    x1 = x[..., :half].astype(jnp.float32)
    x2 = x[..., half:ROT_DIM].astype(jnp.float32)
    rot = jnp.concatenate([x1 * cos - x2 * sin, x2 * cos + x1 * sin], axis=-1).astype(x.dtype)
    return jnp.concatenate([rot, x[..., ROT_DIM:]], axis=-1)


def sgu_mixer(u, v, ln_g, ln_b, w_s, b_s):
    bsz, s, _ = u.shape
    nc = s // SGU_CHUNK
    u = jax.nn.gelu(u)
    v = layernorm(jax.nn.gelu(v), ln_g, ln_b)
    vc = v.reshape(bsz, nc, SGU_CHUNK, SGU_GROUPS, MIX_W // SGU_GROUPS)
    causal = jnp.tril(jnp.ones((SGU_CHUNK, SGU_CHUNK), dtype=bool))
    w = jnp.where(causal[None], w_s, 0)
    z = jnp.einsum('gts,bnsgc->bntgc', w, vc) + b_s.T[None, None, :, :, None]
    return u * z.reshape(bsz, s, MIX_W)


def swa_sink_attention(q, k, v, qn_g, kn_g, sinks, cos, sin):
    bsz, s, _ = q.shape
    nb = s // WINDOW
    grp = N_Q_HEADS // N_KV_HEADS
    q = apply_partial_rope(rmsnorm(q.reshape(bsz, s, N_Q_HEADS, HEAD_DIM), qn_g), cos, sin)
    k = apply_partial_rope(rmsnorm(k.reshape(bsz, s, N_KV_HEADS, HEAD_DIM), kn_g), cos, sin)
    v = v.reshape(bsz, s, N_KV_HEADS, HEAD_DIM)
    qb = q.reshape(bsz, nb, WINDOW, N_KV_HEADS, grp, HEAD_DIM)

    def band(t):
        tb = t.reshape(bsz, nb, WINDOW, N_KV_HEADS, HEAD_DIM)
        prev = jnp.pad(tb, ((0, 0), (1, 0), (0, 0), (0, 0), (0, 0)))[:, :-1]
        return jnp.concatenate([prev, tb], axis=2)

    kb, vb = band(k), band(v)
    sc = jnp.einsum('bnqhgd,bnkhd->bnhgqk', qb, kb, preferred_element_type=jnp.float32) * (HEAD_DIM ** -0.5)
    qi = jnp.arange(WINDOW)[:, None]
    ki = jnp.arange(2 * WINDOW)[None, :]
    diff = qi + WINDOW - ki
    in_win = (diff >= 0) & (diff < WINDOW)
    first = (jnp.arange(nb) == 0)[:, None, None]
    valid = in_win[None] & ~(first & (ki < WINDOW)[None])
    sc = jnp.where(valid[None, :, None, None], sc, -jnp.inf)
    sink = sinks.astype(jnp.float32).reshape(N_KV_HEADS, grp)[None, None, :, :, None, None]
    m = jnp.maximum(jnp.max(sc, axis=-1, keepdims=True), sink)
    p = jnp.exp(sc - m)
    p = p / (jnp.sum(p, axis=-1, keepdims=True) + jnp.exp(sink - m))
    o = jnp.einsum('bnhgqk,bnkhd->bnqhgd', p.astype(vb.dtype), vb)
    return o.reshape(bsz, s, N_Q_HEADS * HEAD_DIM)


def short_conv_mixer(b_gate, c_gate, xin, w3):
    return c_gate * causal_dwconv(b_gate * xin, w3)


def conformer_conv(a, gate, w31, b31, cn_g, cn_b):
    y = a * jax.nn.sigmoid(gate)
    y = causal_dwconv(y, w31) + b31
    return jax.nn.silu(layernorm(y, cn_g, cn_b))


def mixing_block(h, cos, sin, w_in, sgu_ln_g, sgu_ln_b, sgu_w, sgu_b, q_norm_g, k_norm_g, sinks,
                 conv3_w, conv31_w, conv31_b, cnorm_g, cnorm_b, w_branch, w_gate, b_gate, w_o):
    bsz, s, _ = h.shape
    a_u, a_v, b_q, b_k, b_v, c_b, c_c, c_x, d_a, d_g = split_cols(h @ w_in)
    y_a = sgu_mixer(a_u, a_v, sgu_ln_g, sgu_ln_b, sgu_w, sgu_b)
    y_b = swa_sink_attention(b_q, b_k, b_v, q_norm_g, k_norm_g, sinks, cos, sin)
    y_c = short_conv_mixer(c_b, c_c, c_x, conv3_w)
    y_d = conformer_conv(d_a, d_g, conv31_w, conv31_b, cnorm_g, cnorm_b)
    ys = jnp.stack([y_a, y_b, y_c, y_d], axis=2)
    gates = jax.nn.sigmoid(h @ w_gate + b_gate).reshape(bsz, s, N_BRANCH, D_MODEL)
    merged = jnp.einsum('bsnc,ncd,bsnd->bsd', ys, w_branch, gates)
    return merged @ w_o


def hier_moe(h, w_group, b_group, w_expert, b_expert, w_e_gate, w_e_up, w_e_down):
    bsz, s, d = h.shape
    t = h.reshape(-1, d)
    g_logits = (t @ w_group + b_group).astype(jnp.float32)
    g_idx = jnp.argmax(g_logits, axis=-1)
    g_w = jnp.take_along_axis(jax.nn.softmax(g_logits, axis=-1), g_idx[:, None], axis=-1)
    e_logits = (t @ w_expert + b_expert).astype(jnp.float32).reshape(-1, N_GROUPS, EXPERTS_PER_GROUP)
    e_in = jnp.take_along_axis(e_logits, g_idx[:, None, None], axis=1)[:, 0]
    top_v, top_i = lax.top_k(e_in, TOP_K)
    top_w = jax.nn.softmax(top_v, axis=-1) * g_w
    expert_id = g_idx[:, None] * EXPERTS_PER_GROUP + top_i
    combine = jnp.sum(jax.nn.one_hot(expert_id, N_EXPERTS, dtype=jnp.float32) * top_w[..., None], axis=1)
    hid = jax.nn.silu(jnp.einsum('td,edf->tef', t, w_e_gate)) * jnp.einsum('td,edf->tef', t, w_e_up)
    out = jnp.einsum('tef,efd,te->td', hid, w_e_down, combine.astype(t.dtype))
    return out.reshape(bsz, s, d)


def setup_inputs(seed: int = 0) -> dict:
    key = jax.random.key(seed)
    ks = jax.random.split(key, 32)
    L = DEPTH
    f32 = jnp.float32

    def nrm(k, shape, scale):
        return jax.random.normal(k, shape, dtype=f32) * scale

    def gain(k, shape):
        return 1.0 + nrm(k, shape, 0.02)

    return {
        'x': nrm(ks[0], (BATCH, SEQ, D_MODEL), 1.0),
        'positions': jnp.broadcast_to(jnp.arange(SEQ, dtype=jnp.int32)[None], (BATCH, SEQ)),
        'norm1_g': gain(ks[1], (L, D_MODEL)),
        'w_in': nrm(ks[2], (L, D_MODEL, D_IN), D_MODEL ** -0.5),
        'sgu_ln_g': gain(ks[3], (L, MIX_W)),
        'sgu_ln_b': nrm(ks[4], (L, MIX_W), 0.02),
        'sgu_w': nrm(ks[5], (L, SGU_GROUPS, SGU_CHUNK, SGU_CHUNK), SGU_CHUNK ** -0.5),
        'sgu_b': gain(ks[6], (L, SGU_GROUPS, SGU_CHUNK)),
        'q_norm_g': gain(ks[7], (L, HEAD_DIM)),
        'k_norm_g': gain(ks[8], (L, HEAD_DIM)),
        'sinks': nrm(ks[9], (L, N_Q_HEADS), 0.5),
        'conv3_w': nrm(ks[10], (L, SHORT_CONV, MIX_W), SHORT_CONV ** -0.5),
        'conv31_w': nrm(ks[11], (L, CONFORMER_CONV, MIX_W), CONFORMER_CONV ** -0.5),
        'conv31_b': nrm(ks[12], (L, MIX_W), 0.02),
        'cnorm_g': gain(ks[13], (L, MIX_W)),
        'cnorm_b': nrm(ks[14], (L, MIX_W), 0.02),
        'w_branch': nrm(ks[15], (L, N_BRANCH, MIX_W, D_MODEL), MIX_W ** -0.5),
        'w_gate': nrm(ks[16], (L, D_MODEL, N_BRANCH * D_MODEL), D_MODEL ** -0.5),
        'b_gate': nrm(ks[17], (L, N_BRANCH * D_MODEL), 0.02),
        'w_o': nrm(ks[18], (L, D_MODEL, D_MODEL), D_MODEL ** -0.5),
        'norm2_g': gain(ks[19], (L, D_MODEL)),
        'w_group': nrm(ks[20], (L, D_MODEL, N_GROUPS), D_MODEL ** -0.5),
        'b_group': nrm(ks[21], (L, N_GROUPS), 0.01),
        'w_expert': nrm(ks[22], (L, D_MODEL, N_EXPERTS), D_MODEL ** -0.5),
        'b_expert': nrm(ks[23], (L, N_EXPERTS), 0.01),
        'w_e_gate': nrm(ks[24], (L, N_EXPERTS, D_MODEL, D_EXPERT), D_MODEL ** -0.5),
        'w_e_up': nrm(ks[25], (L, N_EXPERTS, D_MODEL, D_EXPERT), D_MODEL ** -0.5),
        'w_e_down': nrm(ks[26], (L, N_EXPERTS, D_EXPERT, D_MODEL), D_EXPERT ** -0.5),
    }


def reference(x, positions, norm1_g, w_in, sgu_ln_g, sgu_ln_b, sgu_w, sgu_b, q_norm_g, k_norm_g, sinks,
              conv3_w, conv31_w, conv31_b, cnorm_g, cnorm_b, w_branch, w_gate, b_gate, w_o,
              norm2_g, w_group, b_group, w_expert, b_expert, w_e_gate, w_e_up, w_e_down):
    cos, sin = rope_tables(positions)
    for l in range(DEPTH):
        h = rmsnorm(x, norm1_g[l])
        x = x + mixing_block(h, cos, sin, w_in[l], sgu_ln_g[l], sgu_ln_b[l], sgu_w[l], sgu_b[l],
                             q_norm_g[l], k_norm_g[l], sinks[l], conv3_w[l], conv31_w[l], conv31_b[l],
                             cnorm_g[l], cnorm_b[l], w_branch[l], w_gate[l], b_gate[l], w_o[l])
        h = rmsnorm(x, norm2_g[l])
        x = x + hier_moe(h, w_group[l], b_group[l], w_expert[l], b_expert[l],
                         w_e_gate[l], w_e_up[l], w_e_down[l])
    return x
```

```cpp
#include <hip/hip_runtime.h>
#include <cstdio>
#include <cstdint>

#ifndef ABL
#define ABL 0
#endif
#ifndef MK_PER_PHASE
#define MK_PER_PHASE 0
#endif

#define LAS __attribute__((address_space(3)))
#define GAS __attribute__((address_space(1)))
typedef unsigned short bf16_t;
typedef short bf16x8 __attribute__((ext_vector_type(8)));
typedef float f32x4 __attribute__((ext_vector_type(4)));
typedef float f32x2 __attribute__((ext_vector_type(2)));
typedef unsigned u32x4 __attribute__((ext_vector_type(4)));
typedef unsigned u32x2 __attribute__((ext_vector_type(2)));

constexpr int NB = 8, SEQ = 4096, D = 1024, NTOK = NB * SEQ, DEPTH = 2;
constexpr int DIN = 2304, PS = 1792;
constexpr int P_U = 0, P_GV = 256, P_Q = 512, P_K = 768, P_V = 896, P_BX = 1024, P_CC = 1280, P_GLU = 1536;
constexpr int NEXP = 16, DEXP = 256, NBUCKET = 24;
constexpr int MPAD_MAX = NTOK + NBUCKET * 256;
constexpr float EPS = 1e-6f;

typedef __bf16 bf16x2_t __attribute__((ext_vector_type(2)));
__device__ __forceinline__ unsigned cvt_pk_bf16(float lo, float hi) { const bf16x2_t v = {(__bf16)lo, (__bf16)hi}; return __builtin_bit_cast(unsigned, v); }
__device__ __forceinline__ float bf_lo(unsigned w) { return __uint_as_float(w << 16); }
__device__ __forceinline__ float bf_hi(unsigned w) { return __uint_as_float(w & 0xffff0000u); }
__device__ __forceinline__ float bf2f(bf16_t h) { return __uint_as_float(((unsigned)h) << 16); }
__device__ __forceinline__ float sigmoid_f(float x) { return __builtin_amdgcn_rcpf(1.0f + __builtin_amdgcn_exp2f(-1.44269504089f * x)); }
__device__ __forceinline__ float gelu_tanh_f(float x) {
    const float t = x * (1.0f + 0.044715f * x * x); return x * sigmoid_f(1.5957691216f * t); }
__device__ __forceinline__ float silu_f(float x) { return x * sigmoid_f(x); }

__device__ __forceinline__ int lane_id_now() { int l; asm volatile("v_mbcnt_lo_u32_b32 %0, -1, 0\n\tv_mbcnt_hi_u32_b32 %0, -1, %0" : "=v"(l)); return l; }
template <int CTRL> __device__ __forceinline__ float dpp_f(float v) { return __int_as_float(__builtin_amdgcn_mov_dpp(__float_as_int(v), CTRL, 0xf, 0xf, true)); }
__device__ __forceinline__ float xor16_f(float v) { return __int_as_float(__builtin_amdgcn_ds_swizzle(__float_as_int(v), 0x401F)); }
__device__ __forceinline__ float sum_xor32_f(float v) { const auto r = __builtin_amdgcn_permlane32_swap(__float_as_uint(v), __float_as_uint(v), false, false); return __uint_as_float(r[0]) + __uint_as_float(r[1]); }
__device__ __forceinline__ float wave_sum(float v) {
    v += dpp_f<0xB1>(v); v += dpp_f<0x4E>(v); v += dpp_f<0x141>(v); v += dpp_f<0x140>(v);
    v += xor16_f(v); return sum_xor32_f(v);
}

namespace pg8 {
constexpr int BM = 256, BK = 64, HALF = 128, HTB = HALF * BK * 2  , STAGE_BYTES = 8 * HTB, NXCD = 8, WGM = 8;
__host__ __device__ __forceinline__ int lds_byte(int r, int c) { const int st = (r >> 4) * 2 + (c >> 5), rr = r & 15, cc = c & 31, ob = rr * 64 + cc * 2; return st * 1024 + (ob ^ (((ob >> 9) & 1) << 5)); }
__host__ __device__ __forceinline__ void stage_rc(int b, int& R, int& C) { const int st = b / 1024, sb = b % 1024, swz = sb ^ (((sb >> 9) & 1) << 5); R = (st >> 1) * 16 + swz / 64; C = (st & 1) * 32 + (swz % 64) / 2; }
__host__ __device__ __forceinline__ int perm32(int rho) { const int n = rho >> 4, i = rho & 15; return 8 * (i >> 2) + 4 * n + (i & 3); }

struct Unit { int pm, pn, aux; };

__device__ __forceinline__ void tile_of(int L, int nM, int nN, int& pm, int& pn) {
    const int nwg = nM * nN; int wgid = L; { const int q = nwg / NXCD, r = nwg % NXCD, xcd = wgid % NXCD, off = wgid / NXCD; wgid = (xcd < r ? xcd * (q + 1) : r * (q + 1) + (xcd - r) * q) + off; }
    const int nig = WGM * nN, gid = wgid / nig, fm = gid * WGM, gsz = (nM - fm) < WGM ? (nM - fm) : WGM;
    pm = fm + ((wgid % nig) % gsz); pn = (wgid % nig) / gsz;
}

template <class Epi, class Sched>
__device__ __forceinline__ void gemm_phase(LAS unsigned char* lds, const int wid  , const int K, const int lda, const int ldb, const Sched& S, const Epi& E) {
    const int lane = lane_id_now(), tid = wid * 64 + lane;
    const int wr = wid >> 2, wc = wid & 3, fr = lane & 15, fq = lane >> 4;
    int nt = K / BK; asm volatile("" : "+s"(nt));
    unsigned voffA[2], voffB[2];
#pragma unroll
    for (int i = 0; i < 2; ++i) { int R, C; stage_rc(tid * 16 + i * 8192, R, C); const int Rb = Epi::PERM ? ((R & ~31) + perm32(R & 31)) : R;
        voffA[i] = (unsigned)(R * lda + C) * 2u; voffB[i] = (unsigned)(Rb * ldb + C) * 2u; }
    asm volatile("" : "+v"(voffA[0]), "+v"(voffA[1]), "+v"(voffB[0]), "+v"(voffB[1]));
    const size_t kstep = (size_t)(BK * 2);
    const size_t hstepA = (size_t)HALF * lda * 2, hstepB = (size_t)HALF * ldb * 2;
    const unsigned ldsw = (unsigned)wid * 1024u;
    const int aoff = lds_byte(wr * 64 + fr, fq * 8), boff = lds_byte(wc * 32 + fr, fq * 8);
#define PG8_SA(b, h) (((b) * 2 + (h)) * HTB)
#define PG8_SB(b, h) ((4 + (b) * 2 + (h)) * HTB)
#define PG8_STAGE(bufoff, gbase, voff) do { _Pragma("unroll") for (int _i = 0; _i < 2; ++_i) \
        __builtin_amdgcn_global_load_lds((const unsigned*)((const char*)(gbase) + (voff)[_i]), (LAS unsigned*)(lds + (bufoff) + ldsw + _i * 8192), 16, 0, 0); } while (0)
#define PG8_LDA(dst, b, h) do { _Pragma("unroll") for (int m = 0; m < 4; ++m) _Pragma("unroll") for (int k = 0; k < 2; ++k) dst[m][k] = *(const LAS bf16x8*)(lds + PG8_SA(b, h) + aoff + m * 2048 + k * 1024); } while (0)
#define PG8_LDB(dst, b, h) do { _Pragma("unroll") for (int n = 0; n < 2; ++n) _Pragma("unroll") for (int k = 0; k < 2; ++k) dst[n][k] = *(const LAS bf16x8*)(lds + PG8_SB(b, h) + boff + n * 2048 + k * 1024); } while (0)
#define PG8_MMA(ai, bj, At, Bt) do { __builtin_amdgcn_s_setprio(1); _Pragma("unroll") for (int m = 0; m < 4; ++m) _Pragma("unroll") for (int n = 0; n < 2; ++n) _Pragma("unroll") for (int k = 0; k < 2; ++k) \
        acc[ai][bj][m][n] = __builtin_amdgcn_mfma_f32_16x16x32_bf16(Bt[n][k], At[m][k], acc[ai][bj][m][n], 0, 0, 0); __builtin_amdgcn_s_setprio(0); } while (0)
#define PG8_WAIT_V(n) asm volatile("s_waitcnt vmcnt(" #n ")" ::: "memory")
#define PG8_WAIT_L(n) asm volatile("s_waitcnt lgkmcnt(" #n ")" ::: "memory")
#define PG8_BAR __builtin_amdgcn_s_barrier()
#define PG8_SCHED __builtin_amdgcn_sched_barrier(0)
    Unit cur, nxt; int ui = 0;
    if (!S.next(0, cur)) return;
    f32x4 acc[2][2][4][2];
#pragma unroll
    for (int a = 0; a < 2; ++a)
#pragma unroll
        for (int b = 0; b < 2; ++b)
#pragma unroll
            for (int m = 0; m < 4; ++m)
#pragma unroll
                for (int n = 0; n < 2; ++n) acc[a][b][m][n] = (f32x4){0.f, 0.f, 0.f, 0.f};
    bf16x8 At[4][2], B0[2][2], B1[2][2];
    const char* cA = S.a_ptr(cur); const char* cB = S.b_ptr(cur);
    PG8_STAGE(PG8_SB(0, 0), cB, voffB); PG8_STAGE(PG8_SB(0, 1), cB + hstepB, voffB); PG8_STAGE(PG8_SA(0, 0), cA, voffA); PG8_STAGE(PG8_SA(0, 1), cA + hstepA, voffA);
    if (wr == 1) PG8_BAR;
    PG8_WAIT_V(2); PG8_BAR;
    PG8_STAGE(PG8_SB(1, 0), cB + kstep, voffB); PG8_STAGE(PG8_SA(1, 0), cA + kstep, voffA); PG8_STAGE(PG8_SB(1, 1), cB + hstepB + kstep, voffB);
    PG8_WAIT_V(6); PG8_BAR;
    for (;;) {
        const bool has_next = S.next(ui + 1, nxt);
        const char* nA = has_next ? S.a_ptr(nxt) : cA; const char* nB = has_next ? S.b_ptr(nxt) : cB;
        const char* cB2 = cB; int segT = nt;
        if constexpr (Sched::TWO_SEG) { segT = S.seg_tiles(); cB2 = S.b_ptr2(cur) - (size_t)segT * kstep; }
        for (int t = 0; t < nt; t += 2) {
            const bool last = (t == nt - 2);
            const char* a1 = cA + (size_t)(t + 1) * kstep;
            const char* bsrc = (t + 2 >= segT) ? cB2 : cB;
            const char* a2 = last ? nA : cA + (size_t)(t + 2) * kstep; const char* b2 = last ? nB : bsrc + (size_t)(t + 2) * kstep;
            const char* a3 = a2 + kstep; const char* b3 = b2 + kstep;
            PG8_LDB(B0, 0, 0); PG8_LDB(B1, 0, 1); PG8_SCHED; PG8_LDA(At, 0, 0); PG8_STAGE(PG8_SA(1, 1), a1 + hstepA, voffA);
            PG8_WAIT_V(8); PG8_WAIT_L(0); PG8_BAR; PG8_MMA(0, 0, At, B0); PG8_MMA(0, 1, At, B1); PG8_BAR; PG8_SCHED;
            PG8_LDA(At, 0, 1); PG8_STAGE(PG8_SB(0, 0), b2, voffB); PG8_STAGE(PG8_SB(0, 1), b2 + hstepB, voffB); PG8_STAGE(PG8_SA(0, 0), a2, voffA);
            PG8_WAIT_V(8); PG8_WAIT_L(0); PG8_BAR; PG8_MMA(1, 0, At, B0); PG8_MMA(1, 1, At, B1); PG8_BAR; PG8_SCHED;
            PG8_LDB(B0, 1, 0); PG8_LDB(B1, 1, 1); PG8_SCHED; PG8_LDA(At, 1, 0); PG8_STAGE(PG8_SA(0, 1), a2 + hstepA, voffA);
            PG8_WAIT_V(8); PG8_WAIT_L(0); PG8_BAR; PG8_MMA(0, 0, At, B0); PG8_MMA(0, 1, At, B1); PG8_BAR; PG8_SCHED;
            PG8_LDA(At, 1, 1); PG8_STAGE(PG8_SB(1, 0), b3, voffB); PG8_STAGE(PG8_SB(1, 1), b3 + hstepB, voffB); PG8_STAGE(PG8_SA(1, 0), a3, voffA);
            PG8_WAIT_V(8); PG8_WAIT_L(0); PG8_BAR; PG8_MMA(1, 0, At, B0); PG8_MMA(1, 1, At, B1); PG8_BAR; PG8_SCHED;
        }
        if (wr == 0) PG8_BAR;
        { const int le = lane_id_now(); E(acc, cur, wr, wc, le & 15, le >> 4); }
        if (!has_next) break;
#pragma unroll
        for (int a = 0; a < 2; ++a)
#pragma unroll
            for (int b = 0; b < 2; ++b)
#pragma unroll
                for (int m = 0; m < 4; ++m)
#pragma unroll
                    for (int n = 0; n < 2; ++n) acc[a][b][m][n] = (f32x4){0.f, 0.f, 0.f, 0.f};
        cur = nxt; cA = nA; cB = nB; ++ui;
        if (wr == 1) PG8_BAR;
    }
    PG8_WAIT_V(0);
    PG8_BAR;
#undef PG8_SA
#undef PG8_SB
#undef PG8_STAGE
#undef PG8_LDA
#undef PG8_LDB
#undef PG8_MMA
#undef PG8_WAIT_V
#undef PG8_WAIT_L
#undef PG8_BAR
#undef PG8_SCHED
}
}

constexpr size_t MiB = 1u << 20;
constexpr size_t WS_CTL = 0, CTL_ZERO_BYTES = 1 * MiB;
constexpr size_t WS_AUX = 1 * MiB;
constexpr size_t AUX_RS = WS_AUX, AUX_BKT = AUX_RS + 131072, AUX_WLO = AUX_BKT + 131072, AUX_WHI = AUX_WLO + 131072,
                 AUX_STOK = AUX_WHI + 131072, AUX_SW = AUX_STOK + 163840, AUX_TB = AUX_SW + 327680;
constexpr size_t WS_ROPE = 2 * MiB;
constexpr size_t WS_W = 4 * MiB;
constexpr size_t W_IN = 0, W_GATE = W_IN + (size_t)DIN * D * 2, W_BR = W_GATE + (size_t)4096 * D * 2, W_O = W_BR + (size_t)4 * D * 256 * 2,
                 W_GU = W_O + (size_t)D * D * 2, W_DN = W_GU + (size_t)NEXP * 512 * D * 2, W_LAYER = W_DN + (size_t)NEXP * D * 256 * 2;
constexpr size_t WS_SGU = WS_W + 2 * W_LAYER;
constexpr size_t WS_BIG = 86 * MiB;
constexpr size_t BIG_X1 = WS_BIG, BIG_H2S = BIG_X1 + (size_t)NTOK * D * 4, BIG_HID = BIG_H2S + (size_t)MPAD_MAX * D * 2;
constexpr size_t WS_HM = 342 * MiB;
constexpr size_t WS_YS = 406 * MiB;
constexpr size_t WS_END = 470 * MiB;
static_assert(WS_SGU + 262144 <= WS_BIG && BIG_HID + (size_t)MPAD_MAX * 512 * 2 <= WS_HM && AUX_TB + 1024 <= WS_ROPE, "d_ws map");
constexpr int CW_BAR = 4096;
constexpr int CW_CNT = 8192;

constexpr int RING_BYTES = 131072;
constexpr int LDSCTL_OFF = RING_BYTES;
constexpr int LDS_BYTES = 147456;
constexpr int NWAVES = 8, NTHREADS = 512;

#define XB_TMO      128
#define XB_XCNT(j)  (256  + 64 * (j))
#define XB_XSUB(j)  (1280 + 64 * (j))
#define XB_XGEN(j)  (2304 + 64 * (j))
#define XB_TOP      3328
#define XB_TOPGEN   3392
#define XCD_BAR_WORDS 3456
#define XB_SPIN_CAP (1u << 18)

__device__ __forceinline__ unsigned xb_ld(unsigned* p)              { return __hip_atomic_load(p, __ATOMIC_RELAXED, __HIP_MEMORY_SCOPE_AGENT); }
__device__ __forceinline__ unsigned xb_add(unsigned* p, unsigned v) { return __hip_atomic_fetch_add(p, v, __ATOMIC_RELAXED, __HIP_MEMORY_SCOPE_AGENT); }
__device__ __forceinline__ unsigned xb_xcc_id() { return (unsigned)__builtin_amdgcn_s_getreg((3 << 11) | 20) & 0xFu; }
#define XB_SPIN(cond, bar) do { unsigned _sp = 0; while (cond) { __builtin_amdgcn_s_sleep(1); \
    if ((++_sp & 255u) == 0u) { if (xb_ld(&(bar)[XB_TMO])) break; if (_sp > XB_SPIN_CAP) { atomicAdd(&(bar)[XB_TMO], 1u); break; } } } } while (0)

struct XcdBarrier {
    unsigned* bar; unsigned x; int wave;
    volatile LAS unsigned* st;
};
__device__ __forceinline__ XcdBarrier xcd_barrier_post(unsigned* bar, volatile LAS unsigned* st) {
    XcdBarrier b; b.bar = bar; b.x = xb_xcc_id(); b.st = st; b.wave = __builtin_amdgcn_readfirstlane((int)threadIdx.x >> 6);
    if (threadIdx.x == 0) (void)xb_add(&bar[XB_XCNT(b.x)], 1u);
    return b;
}
__device__ __forceinline__ void xcd_barrier_complete(unsigned* bar, unsigned x, unsigned& nloc, unsigned& nx) {
    const unsigned G = gridDim.x * gridDim.y * gridDim.z;
    unsigned sum, cnt, mine, sp = 0u;
    for (;;) {
        sum = 0u; cnt = 0u; mine = 0u;
#pragma unroll
        for (unsigned j = 0; j < 16; ++j) { const unsigned c = xb_ld(&bar[XB_XCNT(j)]); sum += c; cnt += (c > 0u) ? 1u : 0u; mine = (j == x) ? c : mine; }
        if (sum == G) break;
        __builtin_amdgcn_s_sleep(1);
        if ((++sp & 255u) == 0u) { if (xb_ld(&bar[XB_TMO])) break; if (sp > XB_SPIN_CAP) { atomicAdd(&bar[XB_TMO], 1u); break; } }
    }
    nloc = mine > 0u ? mine : 1u; nx = cnt > 0u ? cnt : 1u;
}
__device__ __forceinline__ void xcd_barrier(const XcdBarrier& b) {
    asm volatile("s_waitcnt vmcnt(0)" ::: "memory");
    __syncthreads();
    if (b.wave == 0 && lane_id_now() == 0) {
        unsigned* bar = b.bar;
        __builtin_amdgcn_s_waitcnt(0);
        unsigned nloc = b.st[0], nx = b.st[1];
        if (nloc == 0u) { xcd_barrier_complete(bar, b.x, nloc, nx); b.st[0] = nloc; b.st[1] = nx; }
        const unsigned old = xb_add(&bar[XB_XSUB(b.x)], 1u);
        const unsigned gen = old / nloc;
        if (old + 1u == (gen + 1u) * nloc) {
            __builtin_amdgcn_fence(__ATOMIC_RELEASE, "agent");
            asm volatile("s_waitcnt vmcnt(0)" ::: "memory");
            const unsigned og = xb_add(&bar[XB_TOP], 1u);
            const unsigned tg = og / nx;
            if (og + 1u == (tg + 1u) * nx) xb_add(&bar[XB_TOPGEN], 1u);
            else XB_SPIN(xb_ld(&bar[XB_TOPGEN]) == tg, bar);
            __builtin_amdgcn_fence(__ATOMIC_ACQUIRE, "agent");
            xb_add(&bar[XB_XGEN(b.x)], 1u);
            asm volatile("s_waitcnt vmcnt(0)" ::: "memory");
        } else {
            XB_SPIN(xb_ld(&bar[XB_XGEN(b.x)]) == gen, bar);
            __builtin_amdgcn_fence(__ATOMIC_ACQUIRE, "agent");
            asm volatile("s_waitcnt vmcnt(0)" ::: "memory");
        }
    }
    __syncthreads();
}

struct PlainOrder {
    static constexpr bool TWO_SEG = false;
    const char* A; const char* Bt; int nM, nN, G, c; size_t tA, tB;
    __device__ __forceinline__ bool next(int i, pg8::Unit& u) const { const int L = i * G + c; if (L >= nM * nN) return false; pg8::tile_of(L, nM, nN, u.pm, u.pn); u.aux = 0; return true; }
    __device__ __forceinline__ const char* a_ptr(const pg8::Unit& u) const { return A + (size_t)u.pm * tA; }
    __device__ __forceinline__ const char* b_ptr(const pg8::Unit& u) const { return Bt + (size_t)u.pn * tB; }
};
struct BranchOrder {
    static constexpr bool TWO_SEG = false;
    const char* ys; const char* wb; int G, c;
    __device__ __forceinline__ bool next(int i, pg8::Unit& u) const { const int L = (i >> 2) * G + c; if (L >= 128 * 4) return false; pg8::tile_of(L, 128, 4, u.pm, u.pn); u.aux = i & 3; return true; }
    __device__ __forceinline__ const char* a_ptr(const pg8::Unit& u) const { return ys + (size_t)u.pm * (256 * 1024 * 2) + (size_t)u.aux * 512; }
    __device__ __forceinline__ const char* b_ptr(const pg8::Unit& u) const { return wb + (size_t)(u.aux * 1024 + u.pn * 256) * 512; }
};
__device__ __forceinline__ void bucket_experts(int bucket, int& e1, int& e2) {
    const int g = bucket / 6, pr = bucket - 6 * g;
    const int a = pr < 3 ? 0 : (pr < 5 ? 1 : 2), b = pr < 3 ? pr + 1 : (pr < 5 ? pr - 1 : 3);
    e1 = 4 * g + a; e2 = 4 * g + b;
}
struct MoeUpOrder {
    static constexpr bool TWO_SEG = false;
    const char* h2s; const char* wgu; unsigned* tile_bucket; int nTiles, G, vcu;
    __device__ __forceinline__ bool next(int i, pg8::Unit& u) const { const int L = i * G + vcu; if (L >= nTiles * 4) return false; u.pm = L >> 2; u.pn = L & 3;
        u.aux = __builtin_amdgcn_readfirstlane((int)__hip_atomic_load(tile_bucket + u.pm, __ATOMIC_RELAXED, __HIP_MEMORY_SCOPE_AGENT)); return true; }
    __device__ __forceinline__ const char* a_ptr(const pg8::Unit& u) const { return h2s + (size_t)u.pm * (256 * 1024 * 2); }
    __device__ __forceinline__ const char* b_ptr(const pg8::Unit& u) const { int e1, e2; bucket_experts(u.aux, e1, e2); const int e = u.pn < 2 ? e1 : e2; return wgu + (size_t)(e * 512 + (u.pn & 1) * 256) * 2048; }
};
struct MoeDownOrder {
    static constexpr bool TWO_SEG = true;
    const char* hid; const char* wdn; unsigned* tile_bucket; int nTiles, G, vcu;
    __device__ __forceinline__ bool next(int i, pg8::Unit& u) const { const int L = i * G + vcu; if (L >= nTiles * 4) return false; u.pm = L >> 2; u.pn = L & 3;
        u.aux = __builtin_amdgcn_readfirstlane((int)__hip_atomic_load(tile_bucket + u.pm, __ATOMIC_RELAXED, __HIP_MEMORY_SCOPE_AGENT)); return true; }
    __device__ __forceinline__ int seg_tiles() const { return 4; }
    __device__ __forceinline__ const char* a_ptr(const pg8::Unit& u) const { return hid + (size_t)u.pm * (256 * 512 * 2); }
    __device__ __forceinline__ const char* b_ptr(const pg8::Unit& u) const { int e1, e2; bucket_experts(u.aux, e1, e2); return wdn + (size_t)(e1 * 1024 + u.pn * 256) * 512; }
    __device__ __forceinline__ const char* b_ptr2(const pg8::Unit& u) const { int e1, e2; bucket_experts(u.aux, e1, e2); return wdn + (size_t)(e2 * 1024 + u.pn * 256) * 512; }
};

typedef f32x4 Acc[2][2][4][2];
__device__ __forceinline__ u32x4 pack8(const f32x4 a, const f32x4 b) { u32x4 w; w.x = cvt_pk_bf16(a[0], a[1]); w.y = cvt_pk_bf16(a[2], a[3]); w.z = cvt_pk_bf16(b[0], b[1]); w.w = cvt_pk_bf16(b[2], b[3]); return w; }
__device__ __forceinline__ void unpack8(const u32x4 w, f32x4& a, f32x4& b) { a = (f32x4){bf_lo(w.x), bf_hi(w.x), bf_lo(w.y), bf_hi(w.y)}; b = (f32x4){bf_lo(w.z), bf_hi(w.z), bf_lo(w.w), bf_hi(w.w)}; }

struct EpiInProj {
    static constexpr bool PERM = true;
    bf16_t* P; const float* rope; const float* qg; const float* kg;
    __device__ __forceinline__ void operator()(const Acc& acc, const pg8::Unit& u, int wr, int wc, int fr, int fq) const {
        asm volatile("" : "+v"(fr), "+v"(fq));
        const int pn = u.pn, row0 = u.pm * 256 + wr * 64 + fr, c8 = wc * 32 + 8 * fq;
        if (pn == 2 || (pn == 3 && wc < 2)) {
            const float* gp = (pn == 2) ? qg : kg; const float osc = (pn == 2) ? 0.125f : 1.0f;
            f32x4 g[2][2];
#pragma unroll
            for (int bj = 0; bj < 2; ++bj)
#pragma unroll
                for (int n = 0; n < 2; ++n) g[bj][n] = *(const f32x4*)(gp + bj * 32 + 8 * fq + 4 * n);
            const int dcol = (pn == 2 ? P_Q : P_K) + wc * 64 + 8 * fq;
#pragma unroll
            for (int ai = 0; ai < 2; ++ai)
#pragma unroll
                for (int m = 0; m < 4; ++m) {
                    const int row = row0 + ai * 128 + m * 16;
                    float ss = 0.f;
#pragma unroll
                    for (int bj = 0; bj < 2; ++bj)
#pragma unroll
                        for (int n = 0; n < 2; ++n) { const f32x4 v = acc[ai][bj][m][n]; ss += (v[0] * v[0] + v[1] * v[1]) + (v[2] * v[2] + v[3] * v[3]); }
                    ss += xor16_f(ss); ss = sum_xor32_f(ss);
                    const float rs = __builtin_amdgcn_rsqf(ss * (1.0f / 64.0f) + EPS);
                    f32x4 o[2][2];
#pragma unroll
                    for (int bj = 0; bj < 2; ++bj)
#pragma unroll
                        for (int n = 0; n < 2; ++n) o[bj][n] = acc[ai][bj][m][n] * rs * g[bj][n];
                    const float* rp = rope + (size_t)row * 16;
#pragma unroll
                    for (int n = 0; n < 2; ++n) {
                        const f32x4 cs = *(const f32x4*)(rp + 4 * n), sn = *(const f32x4*)(rp + 8 + 4 * n);
                        f32x4 other;
#pragma unroll
                        for (int j = 0; j < 4; ++j) other[j] = xor16_f(o[0][n][j]);
                        const f32x4 rot = (fq == 0) ? (o[0][n] * cs - other * sn) : (o[0][n] * cs + other * sn);
                        if (fq < 2) o[0][n] = rot;
                    }
#pragma unroll
                    for (int bj = 0; bj < 2; ++bj) *(u32x4*)(P + (size_t)row * PS + dcol + bj * 32) = pack8(o[bj][0] * osc, o[bj][1] * osc);
                }
            return;
        }
#pragma unroll
        for (int ai = 0; ai < 2; ++ai)
#pragma unroll
            for (int m = 0; m < 4; ++m) {
                bf16_t* prow = P + (size_t)(row0 + ai * 128 + m * 16) * PS;
                const f32x4 a0 = acc[ai][0][m][0], a1 = acc[ai][0][m][1], b0 = acc[ai][1][m][0], b1 = acc[ai][1][m][1];
                if (pn < 2) {
                    f32x4 x0, x1, y0, y1;
#pragma unroll
                    for (int j = 0; j < 4; ++j) { x0[j] = gelu_tanh_f(a0[j]); x1[j] = gelu_tanh_f(a1[j]); y0[j] = gelu_tanh_f(b0[j]); y1[j] = gelu_tanh_f(b1[j]); }
                    *(u32x4*)(prow + pn * 256 + c8) = pack8(x0, x1); *(u32x4*)(prow + pn * 256 + 128 + c8) = pack8(y0, y1);
                } else if (pn == 3) {
                    const int dc = P_V + (wc - 2) * 64 + 8 * fq;
                    *(u32x4*)(prow + dc) = pack8(a0, a1); *(u32x4*)(prow + dc + 32) = pack8(b0, b1);
                } else if (pn == 4 || pn == 5) {
                    *(u32x4*)(prow + P_BX + (pn - 4) * 128 + c8) = pack8(a0 * b0, a1 * b1);
                } else if (pn == 6) {
                    *(u32x4*)(prow + P_CC + c8) = pack8(a0, a1); *(u32x4*)(prow + P_CC + 128 + c8) = pack8(b0, b1);
                } else {
                    f32x4 x0, x1;
#pragma unroll
                    for (int j = 0; j < 4; ++j) { x0[j] = a0[j] * sigmoid_f(b0[j]); x1[j] = a1[j] * sigmoid_f(b1[j]); }
                    *(u32x4*)(prow + P_GLU + (pn - 7) * 128 + c8) = pack8(x0, x1);
                }
            }
    }
};
struct EpiGate {
    static constexpr bool PERM = true;
    bf16_t* Gm; const float* bias;
    __device__ __forceinline__ void operator()(const Acc& acc, const pg8::Unit& u, int wr, int wc, int fr, int fq) const {
        asm volatile("" : "+v"(fr), "+v"(fq));
        const int row0 = u.pm * 256 + wr * 64 + fr, col0 = u.pn * 256 + wc * 32 + 8 * fq;
        f32x4 bv[2][2];
#pragma unroll
        for (int bj = 0; bj < 2; ++bj)
#pragma unroll
            for (int n = 0; n < 2; ++n) bv[bj][n] = *(const f32x4*)(bias + col0 + bj * 128 + 4 * n);
#pragma unroll
        for (int ai = 0; ai < 2; ++ai)
#pragma unroll
            for (int m = 0; m < 4; ++m) { bf16_t* rowp = Gm + (size_t)(row0 + ai * 128 + m * 16) * 4096 + col0;
#pragma unroll
                for (int bj = 0; bj < 2; ++bj) { f32x4 v0 = acc[ai][bj][m][0] + bv[bj][0], v1 = acc[ai][bj][m][1] + bv[bj][1];
#pragma unroll
                    for (int j = 0; j < 4; ++j) { v0[j] = sigmoid_f(v0[j]); v1[j] = sigmoid_f(v1[j]); }
                    *(u32x4*)(rowp + bj * 128) = pack8(v0, v1); } }
    }
};
struct EpiMerge {
    static constexpr bool PERM = true;
    const bf16_t* Gm; bf16_t* Mg;
    __device__ __forceinline__ void operator()(const Acc& acc, const pg8::Unit& u, int wr, int wc, int fr, int fq) const {
        asm volatile("" : "+v"(fr), "+v"(fq));
        const int row0 = u.pm * 256 + wr * 64 + fr, col0 = u.pn * 256 + wc * 32 + 8 * fq, b = u.aux;
#pragma unroll
        for (int ai = 0; ai < 2; ++ai)
#pragma unroll
            for (int m = 0; m < 4; ++m) { const unsigned row = (unsigned)(row0 + ai * 128 + m * 16);
#pragma unroll
                for (int bj = 0; bj < 2; ++bj) {
                    f32x4 g0, g1; unpack8(*(const u32x4*)(Gm + (row * 4096u + (unsigned)(b * 1024 + col0 + bj * 128))), g0, g1);
                    f32x4 v0 = acc[ai][bj][m][0] * g0, v1 = acc[ai][bj][m][1] * g1;
                    bf16_t* mp = Mg + (row * 1024u + (unsigned)(col0 + bj * 128));
                    if (b > 0) {
                        const unsigned long long q0 = __hip_atomic_load((const unsigned long long*)mp, __ATOMIC_RELAXED, __HIP_MEMORY_SCOPE_AGENT), q1 = __hip_atomic_load((const unsigned long long*)mp + 1, __ATOMIC_RELAXED, __HIP_MEMORY_SCOPE_AGENT);
                        f32x4 p0, p1; unpack8((u32x4){(unsigned)q0, (unsigned)(q0 >> 32), (unsigned)q1, (unsigned)(q1 >> 32)}, p0, p1); v0 += p0; v1 += p1; }
                    *(u32x4*)mp = pack8(v0, v1); }
                asm volatile("" ::: "memory"); }
    }
};
struct EpiWo {
    static constexpr bool PERM = true;
    const float* xin; float* x1;
    __device__ __forceinline__ void operator()(const Acc& acc, const pg8::Unit& u, int wr, int wc, int fr, int fq) const {
        asm volatile("" : "+v"(fr), "+v"(fq));
        const int row0 = u.pm * 256 + wr * 64 + fr, col0 = u.pn * 256 + wc * 32 + 8 * fq;
#pragma unroll
        for (int ai = 0; ai < 2; ++ai)
#pragma unroll
            for (int m = 0; m < 4; ++m) { const unsigned ro = (unsigned)(row0 + ai * 128 + m * 16) * 1024u + (unsigned)col0;
#pragma unroll
                for (int bj = 0; bj < 2; ++bj)
#pragma unroll
                    for (int n = 0; n < 2; ++n) { const unsigned o = ro + bj * 128 + 4 * n; *(f32x4*)(x1 + o) = *(const f32x4*)(xin + o) + acc[ai][bj][m][n]; }
                asm volatile("" ::: "memory"); }
    }
};
struct EpiMoeUp {
    static constexpr bool PERM = true;
    bf16_t* hid; const float* slot_w;
    __device__ __forceinline__ void operator()(const Acc& acc, const pg8::Unit& u, int wr, int wc, int fr, int fq) const {
        asm volatile("" : "+v"(fr), "+v"(fq));
        const int row0 = u.pm * 256 + wr * 64 + fr, col0 = (u.pn >> 1) * 256 + (u.pn & 1) * 128 + wc * 32 + 8 * fq, k = u.pn >> 1;
#pragma unroll
        for (int ai = 0; ai < 2; ++ai)
#pragma unroll
            for (int m = 0; m < 4; ++m) { const size_t row = (size_t)(row0 + ai * 128 + m * 16); const float w = slot_w[row * 2 + k];
                f32x4 x0, x1; const f32x4 a0 = acc[ai][0][m][0], a1 = acc[ai][0][m][1], b0 = acc[ai][1][m][0], b1 = acc[ai][1][m][1];
#pragma unroll
                for (int j = 0; j < 4; ++j) { x0[j] = silu_f(a0[j]) * b0[j] * w; x1[j] = silu_f(a1[j]) * b1[j] * w; }
                *(u32x4*)(hid + row * 512 + col0) = pack8(x0, x1); }
    }
};
struct EpiMoeDown {
    static constexpr bool PERM = true;
    const int* slot_tok; const float* x1; float* out;
    __device__ __forceinline__ void operator()(const Acc& acc, const pg8::Unit& u, int wr, int wc, int fr, int fq) const {
        asm volatile("" : "+v"(fr), "+v"(fq));
        const int row0 = u.pm * 256 + wr * 64 + fr, col0 = u.pn * 256 + wc * 32 + 8 * fq;
#pragma unroll
        for (int ai = 0; ai < 2; ++ai)
#pragma unroll
            for (int m = 0; m < 4; ++m) { const int tok = slot_tok[row0 + ai * 128 + m * 16];
                if (tok >= 0) { const unsigned ro = (unsigned)tok * 1024u + (unsigned)col0;
#pragma unroll
                    for (int bj = 0; bj < 2; ++bj)
#pragma unroll
                        for (int n = 0; n < 2; ++n) { const unsigned o = ro + bj * 128 + 4 * n; *(f32x4*)(out + o) = *(const f32x4*)(x1 + o) + ((ABL & 16) ? acc[ai][bj][m][n] * 0.f : acc[ai][bj][m][n]); } }
                asm volatile("" ::: "memory"); }
    }
};

enum InIdx { I_X = 0, I_POS, I_N1G, I_WIN, I_SLNG, I_SLNB, I_SGUW, I_SGUB, I_QNG, I_KNG, I_SINK, I_C3W, I_C31W, I_C31B, I_CNG, I_CNB, I_WBR, I_WGATE, I_BGATE, I_WO,
             I_N2G, I_WGRP, I_BGRP, I_WEXP, I_BEXP, I_WEG, I_WEU, I_WED, N_IN };
struct Args { const void* in[N_IN]; float* out; unsigned char* ws; int ph_lo, ph_hi; };
struct Frame {
    LAS unsigned char* lds; unsigned char* ws; unsigned* ctl;
    int tid, lane, wave, vcu, G;
};
#define LDS_WAIT() asm volatile("s_waitcnt lgkmcnt(0)" ::: "memory")

__device__ __forceinline__ void p0_transpose_item(const float* W, int N, bf16_t* WT, int Kd, int k0, int n0, int drow0, LAS float* scr, int lane) {
#pragma unroll 8
    for (int i = 0; i < 32; ++i) { const int kk = 2 * i + (lane >> 5); scr[kk * 33 + (lane & 31)] = W[(size_t)(k0 + kk) * N + n0 + (lane & 31)]; }
    LDS_WAIT(); asm volatile("" ::: "memory");
    const int c = lane & 7;
#pragma unroll
    for (int j = 0; j < 4; ++j) { const int n = (lane >> 3) + 8 * j; const LAS float* s = scr + (8 * c) * 33 + n;
        u32x4 o; o.x = cvt_pk_bf16(s[0 * 33], s[1 * 33]); o.y = cvt_pk_bf16(s[2 * 33], s[3 * 33]); o.z = cvt_pk_bf16(s[4 * 33], s[5 * 33]); o.w = cvt_pk_bf16(s[6 * 33], s[7 * 33]);
        *(u32x4*)(WT + (size_t)(drow0 + n) * Kd + k0 + 8 * c) = o; }
    LDS_WAIT(); asm volatile("" ::: "memory");
}
__device__ __forceinline__ int win_dest_row(int s0) {
    if (s0 < 512) return s0;
    if (s0 < 768)  { const int r = s0 - 512, h = r >> 6, bj = (r >> 5) & 1; return 512 + 128 * bj + 32 * h; }
    if (s0 < 896)  { const int r = s0 - 768, h = r >> 6, bj = (r >> 5) & 1; return 768 + 128 * bj + 32 * h; }
    if (s0 < 1024) { const int r = s0 - 896, h = r >> 6, bj = (r >> 5) & 1; return 768 + 128 * bj + 32 * (h + 2); }
    if (s0 < 1280) { const int ch = s0 - 1024; return (4 + (ch >> 7)) * 256 + (ch & 127); }
    if (s0 < 1536) return 6 * 256 + (s0 - 1280);
    if (s0 < 1792) { const int ch = s0 - 1536; return (4 + (ch >> 7)) * 256 + 128 + (ch & 127); }
    if (s0 < 2048) { const int ch = s0 - 1792; return (7 + (ch >> 7)) * 256 + (ch & 127); }
    { const int ch = s0 - 2048; return (7 + (ch >> 7)) * 256 + 128 + (ch & 127); }
}
constexpr int IT_WIN = 16 * 72, IT_WGATE = 16 * 128, IT_WBR = 4 * 4 * 32, IT_WO = 16 * 32, IT_EG = 16 * 16 * 8, IT_EU = IT_EG, IT_ED = 16 * 4 * 32;
constexpr int IT_LAYER = IT_WIN + IT_WGATE + IT_WBR + IT_WO + IT_EG + IT_EU + IT_ED;
__device__ __forceinline__ void p0_weights(const Frame& F0, const Args& a) {
    Frame F = F0; F.lane = lane_id_now(); F.tid = F.wave * 64 + F.lane; asm volatile("" : "+s"(F.G), "+s"(F.vcu));
    LAS float* scr = (LAS float*)(F.lds + F.wave * 16384);
    const int gw = F.vcu * NWAVES + F.wave, NGW = F.G * NWAVES;
    for (int it = gw; it < DEPTH * IT_LAYER; it += NGW) {
        const int l = it / IT_LAYER; int r = it - l * IT_LAYER;
        unsigned char* wl = F.ws + WS_W + (size_t)l * W_LAYER;
        if (r < IT_WIN) { const int kb = r / 72, nb = r % 72; p0_transpose_item((const float*)a.in[I_WIN] + (size_t)l * D * DIN, DIN, (bf16_t*)(wl + W_IN), D, 64 * kb, 32 * nb, win_dest_row(32 * nb), scr, F.lane); continue; } r -= IT_WIN;
        if (r < IT_WGATE) { const int kb = r / 128, nb = r % 128; p0_transpose_item((const float*)a.in[I_WGATE] + (size_t)l * D * 4096, 4096, (bf16_t*)(wl + W_GATE), D, 64 * kb, 32 * nb, 32 * nb, scr, F.lane); continue; } r -= IT_WGATE;
        if (r < IT_WBR) { const int b = r / 128, q = r % 128, kb = q / 32, nb = q % 32; p0_transpose_item((const float*)a.in[I_WBR] + ((size_t)l * 4 + b) * 256 * D, D, (bf16_t*)(wl + W_BR), 256, 64 * kb, 32 * nb, b * 1024 + 32 * nb, scr, F.lane); continue; } r -= IT_WBR;
        if (r < IT_WO) { const int kb = r / 32, nb = r % 32; p0_transpose_item((const float*)a.in[I_WO] + (size_t)l * D * D, D, (bf16_t*)(wl + W_O), D, 64 * kb, 32 * nb, 32 * nb, scr, F.lane); continue; } r -= IT_WO;
        if (r < IT_EG + IT_EU) { const int up = r >= IT_EG; if (up) r -= IT_EG; const int e = r / 128, q = r % 128, kb = q / 8, nb = q % 8, f0 = 32 * nb;
            const float* src = (const float*)a.in[up ? I_WEU : I_WEG] + ((size_t)l * NEXP + e) * D * DEXP;
            p0_transpose_item(src, DEXP, (bf16_t*)(wl + W_GU), D, 64 * kb, f0, e * 512 + (f0 >> 7) * 256 + up * 128 + (f0 & 127), scr, F.lane); continue; } r -= IT_EG + IT_EU;
        { const int e = r / 128, q = r % 128, kb = q / 32, nb = q % 32;
          p0_transpose_item((const float*)a.in[I_WED] + ((size_t)l * NEXP + e) * DEXP * D, D, (bf16_t*)(wl + W_DN), DEXP, 64 * kb, 32 * nb, e * 1024 + 32 * nb, scr, F.lane); }
    }
    const int gt = F.vcu * NTHREADS + F.tid, NGT = F.G * NTHREADS;
    float* rope = (float*)(F.ws + WS_ROPE); const int* pos = (const int*)a.in[I_POS];
    for (int idx = gt; idx < NTOK * 8; idx += NGT) { const int t = idx >> 3, i = idx & 7;
        const float inv = (float)exp2(-(double)i * (18.931568569324174 / 8.0));
        const float ang = (float)pos[t] * inv; float s, c; sincosf(ang, &s, &c);
        rope[(size_t)t * 16 + i] = c; rope[(size_t)t * 16 + 8 + i] = s; }
    bf16_t* sg = (bf16_t*)(F.ws + WS_SGU); const float* sw = (const float*)a.in[I_SGUW];
    for (int idx = gt; idx < DEPTH * 4 * 128 * 128 / 2; idx += NGT) { const int e = idx * 2, s = e & 127, t = (e >> 7) & 127;
        const float v0 = (s <= t) ? sw[e] : 0.f, v1 = (s + 1 <= t) ? sw[e + 1] : 0.f; ((unsigned*)sg)[idx] = cvt_pk_bf16(v0, v1); }
}
__device__ __forceinline__ void norm_rows(const Frame& F0, const float* x, const float* g, bf16_t* h) {
    Frame F = F0; F.lane = lane_id_now(); F.tid = F.wave * 64 + F.lane; asm volatile("" : "+s"(F.G), "+s"(F.vcu));
    const int gw = F.vcu * NWAVES + F.wave, NGW = F.G * NWAVES;
    f32x4 gv[4];
#pragma unroll
    for (int j = 0; j < 4; ++j) gv[j] = *((const f32x4*)g + F.lane + 64 * j);
    for (int m = gw; m < NTOK; m += NGW) {
        const f32x4* xr = (const f32x4*)(x + (size_t)m * D) + F.lane;
        f32x4 v[4]; float s = 0.f;
#pragma unroll
        for (int j = 0; j < 4; ++j) { v[j] = xr[64 * j]; s += (v[j][0] * v[j][0] + v[j][1] * v[j][1]) + (v[j][2] * v[j][2] + v[j][3] * v[j][3]); }
        const float rs = 1.0f / sqrtf(wave_sum(s) * (1.0f / D) + EPS);
        u32x2* o8 = (u32x2*)(h + (size_t)m * D) + F.lane;
#pragma unroll
        for (int j = 0; j < 4; ++j) { const f32x4 y = v[j] * rs * gv[j]; u32x2 o; o.x = cvt_pk_bf16(y[0], y[1]); o.y = cvt_pk_bf16(y[2], y[3]); o8[64 * j] = o; }
    }
}

struct MixArgs { const bf16_t* P; bf16_t* ys; const float *sln_g, *sln_b, *sgu_w, *sgu_b, *sinks, *c3w, *c31w, *c31b, *cn_g, *cn_b; };

__device__ __forceinline__ void mix_sgu(const Frame& F, const MixArgs& A, int t0) {
    LAS float* vln = (LAS float*)F.lds;
    {
        const f32x4 g = *((const f32x4*)A.sln_g + F.lane), b = *((const f32x4*)A.sln_b + F.lane);
        for (int i = 0; i < 16; ++i) { const int r = F.wave * 16 + i;
            const u32x2 w = *((const u32x2*)(A.P + (size_t)(t0 + r) * PS + P_GV) + F.lane);
            f32x4 v = (f32x4){bf_lo(w.x), bf_hi(w.x), bf_lo(w.y), bf_hi(w.y)};
            const float mean = wave_sum((v[0] + v[1]) + (v[2] + v[3])) * (1.0f / 256.0f);
            v = v - mean;
            const float var = wave_sum((v[0] * v[0] + v[1] * v[1]) + (v[2] * v[2] + v[3] * v[3])) * (1.0f / 256.0f);
            const float rstd = 1.0f / sqrtf(var + EPS);
            *((LAS f32x4*)(vln + r * 256) + F.lane) = v * rstd * g + b; }
    }
    __syncthreads();
    const int c = F.tid & 255, th = F.tid >> 8, grp = __builtin_amdgcn_readfirstlane(c >> 6);
    const float* Wg = A.sgu_w + (size_t)grp * 128 * 128; const float* bs = A.sgu_b + grp * 128;
    for (int i = 0; i < 16; ++i) {
        const int tb = 8 * i + th; float a0 = 0.f, a1 = 0.f, a2 = 0.f, a3 = 0.f;
        const float* w0 = Wg + (tb + 0) * 128; const float* w1 = Wg + (tb + 2) * 128; const float* w2 = Wg + (tb + 4) * 128; const float* w3 = Wg + (tb + 6) * 128;
        for (int s = 0; s <= tb + 6; ++s) { const float v = vln[s * 256 + c];
            a0 += (s <= tb + 0 ? w0[s] : 0.f) * v; a1 += (s <= tb + 2 ? w1[s] : 0.f) * v; a2 += (s <= tb + 4 ? w2[s] : 0.f) * v; a3 += w3[s] * v; }
        const float av[4] = {a0, a1, a2, a3};
#pragma unroll
        for (int k = 0; k < 4; ++k) { const int t = tb + 2 * k; const float u = bf2f(A.P[(size_t)(t0 + t) * PS + P_U + c]);
            A.ys[(size_t)(t0 + t) * 1024 + c] = (bf16_t)(cvt_pk_bf16(u * (av[k] + bs[t]), 0.f) & 0xffffu); }
    }
    __syncthreads();
}
__device__ __forceinline__ void mix_attn(const Frame& F, const MixArgs& A, int t0, bool first) {
    LAS bf16_t* Ks = (LAS bf16_t*)F.lds;
    LAS bf16_t* Vs = Ks + 2 * 256 * 64;
    for (int idx = F.tid; idx < 2 * 256 * 8 * 2; idx += NTHREADS) {
        const int ch = idx & 7, j = (idx >> 3) & 255, kvh = (idx >> 11) & 1, isv = idx >> 12;
        u32x4 w = (u32x4){0u, 0u, 0u, 0u};
        if (!(first && j < 128)) w = *(const u32x4*)(A.P + (size_t)(t0 - 128 + j) * PS + (isv ? P_V : P_K) + kvh * 64 + ch * 8);
        *(LAS u32x4*)((isv ? Vs : Ks) + (kvh * 256 + j) * 64 + ch * 8) = w; }
    __syncthreads();
    const int head = __builtin_amdgcn_readfirstlane(F.tid >> 7), q = F.tid & 127, kvh = head >> 1;
    float qv[64], o[64];
    { const u32x4* qp = (const u32x4*)(A.P + (size_t)(t0 + q) * PS + P_Q + head * 64);
#pragma unroll
      for (int c = 0; c < 8; ++c) { const u32x4 w = qp[c]; qv[8 * c + 0] = bf_lo(w.x); qv[8 * c + 1] = bf_hi(w.x); qv[8 * c + 2] = bf_lo(w.y); qv[8 * c + 3] = bf_hi(w.y);
          qv[8 * c + 4] = bf_lo(w.z); qv[8 * c + 5] = bf_hi(w.z); qv[8 * c + 6] = bf_lo(w.w); qv[8 * c + 7] = bf_hi(w.w); } }
#pragma unroll
    for (int d = 0; d < 64; ++d) o[d] = 0.f;
    float mx = A.sinks[head], l = 1.0f;
    const int q0w = __builtin_amdgcn_readfirstlane(q & 64);
    int lo = q0w + 1; const int hi = q0w + 63 + 128; if (first && lo < 128) lo = 128;
    for (int kb = lo; kb <= hi; ++kb) {
        const LAS u32x4* kp = (const LAS u32x4*)(Ks + (kvh * 256 + kb) * 64);
        float s = 0.f;
#pragma unroll
        for (int c = 0; c < 8; ++c) { const u32x4 w = kp[c];
            s += qv[8 * c + 0] * bf_lo(w.x) + qv[8 * c + 1] * bf_hi(w.x) + qv[8 * c + 2] * bf_lo(w.y) + qv[8 * c + 3] * bf_hi(w.y)
               + qv[8 * c + 4] * bf_lo(w.z) + qv[8 * c + 5] * bf_hi(w.z) + qv[8 * c + 6] * bf_lo(w.w) + qv[8 * c + 7] * bf_hi(w.w); }
        if (kb > q && kb <= q + 128) {
            const float mn = fmaxf(mx, s), al = __expf(mx - mn), p = __expf(s - mn);
            l = l * al + p; mx = mn;
            const LAS u32x4* vp = (const LAS u32x4*)(Vs + (kvh * 256 + kb) * 64);
#pragma unroll
            for (int c = 0; c < 8; ++c) { const u32x4 w = vp[c];
                o[8 * c + 0] = o[8 * c + 0] * al + p * bf_lo(w.x); o[8 * c + 1] = o[8 * c + 1] * al + p * bf_hi(w.x); o[8 * c + 2] = o[8 * c + 2] * al + p * bf_lo(w.y); o[8 * c + 3] = o[8 * c + 3] * al + p * bf_hi(w.y);
                o[8 * c + 4] = o[8 * c + 4] * al + p * bf_lo(w.z); o[8 * c + 5] = o[8 * c + 5] * al + p * bf_hi(w.z); o[8 * c + 6] = o[8 * c + 6] * al + p * bf_lo(w.w); o[8 * c + 7] = o[8 * c + 7] * al + p * bf_hi(w.w); }
        }
    }
    const float il = 1.0f / l;
    u32x4* op = (u32x4*)(A.ys + (size_t)(t0 + q) * 1024 + 256 + head * 64);
#pragma unroll
    for (int c = 0; c < 8; ++c) { u32x4 w; w.x = cvt_pk_bf16(o[8 * c] * il, o[8 * c + 1] * il); w.y = cvt_pk_bf16(o[8 * c + 2] * il, o[8 * c + 3] * il);
        w.z = cvt_pk_bf16(o[8 * c + 4] * il, o[8 * c + 5] * il); w.w = cvt_pk_bf16(o[8 * c + 6] * il, o[8 * c + 7] * il); op[c] = w; }
    __syncthreads();
}
__device__ __forceinline__ void mix_conv3(const Frame& F, const MixArgs& A, int t0, bool first) {
    const int c8 = (F.tid & 31) * 8, tq = (F.tid >> 5) * 8;
    f32x4 w[3][2];
#pragma unroll
    for (int j = 0; j < 3; ++j) { w[j][0] = *(const f32x4*)(A.c3w + j * 256 + c8); w[j][1] = *(const f32x4*)(A.c3w + j * 256 + c8 + 4); }
    f32x4 x[10][2];
#pragma unroll
    for (int r = 0; r < 10; ++r) { const int t = tq - 2 + r;
        if (t < 0 && first) { x[r][0] = (f32x4){0.f, 0.f, 0.f, 0.f}; x[r][1] = x[r][0]; }
        else unpack8(*(const u32x4*)(A.P + (size_t)(t0 + t) * PS + P_BX + c8), x[r][0], x[r][1]); }
#pragma unroll
    for (int i = 0; i < 8; ++i) { f32x4 cc0, cc1; unpack8(*(const u32x4*)(A.P + (size_t)(t0 + tq + i) * PS + P_CC + c8), cc0, cc1);
        const f32x4 y0 = w[0][0] * x[i][0] + w[1][0] * x[i + 1][0] + w[2][0] * x[i + 2][0], y1 = w[0][1] * x[i][1] + w[1][1] * x[i + 1][1] + w[2][1] * x[i + 2][1];
        *(u32x4*)(A.ys + (size_t)(t0 + tq + i) * 1024 + 512 + c8) = pack8(cc0 * y0, cc1 * y1); }
}
__device__ __forceinline__ void mix_conv31(const Frame& F, const MixArgs& A, int t0, bool first) {
    LAS bf16_t* gl = (LAS bf16_t*)F.lds;
    for (int idx = F.tid; idx < 158 * 32; idx += NTHREADS) { const int r = idx >> 5, ch = idx & 31;
        u32x4 w = (u32x4){0u, 0u, 0u, 0u};
        if (!(first && r < 30)) w = *(const u32x4*)(A.P + (size_t)(t0 - 30 + r) * PS + P_GLU + ch * 8);
        *(LAS u32x4*)(gl + r * 256 + ch * 8) = w; }
    __syncthreads();
    const int c4 = F.lane * 4, tr = F.wave * 16;
    const f32x4 bias = *(const f32x4*)(A.c31b + c4);
    f32x4 acc[16];
#pragma unroll
    for (int i = 0; i < 16; ++i) acc[i] = bias;
#pragma unroll 1
    for (int j = 0; j < 31; ++j) { const f32x4 w = *(const f32x4*)(A.c31w + j * 256 + c4);
        const LAS bf16_t* xp = gl + (tr + j) * 256 + c4;
#pragma unroll
        for (int i = 0; i < 16; ++i) { const u32x2 p = *(const LAS u32x2*)(xp + i * 256); acc[i] += w * (f32x4){bf_lo(p.x), bf_hi(p.x), bf_lo(p.y), bf_hi(p.y)}; } }
    const f32x4 g = *(const f32x4*)(A.cn_g + c4), b = *(const f32x4*)(A.cn_b + c4);
#pragma unroll
    for (int i = 0; i < 16; ++i) {
        f32x4 v = acc[i];
        const float mean = wave_sum((v[0] + v[1]) + (v[2] + v[3])) * (1.0f / 256.0f);
        v = v - mean;
        const float var = wave_sum((v[0] * v[0] + v[1] * v[1]) + (v[2] * v[2] + v[3] * v[3])) * (1.0f / 256.0f);
        const float rstd = 1.0f / sqrtf(var + EPS);
        v = v * rstd * g + b;
        u32x2 o; o.x = cvt_pk_bf16(silu_f(v[0]), silu_f(v[1])); o.y = cvt_pk_bf16(silu_f(v[2]), silu_f(v[3]));
        *(u32x2*)(A.ys + (size_t)(t0 + tr + i) * 1024 + 768 + c4) = o; }
    __syncthreads();
}
__device__ __forceinline__ void mixer_phase(const Frame& F0, const MixArgs& A) {
    Frame F = F0; F.lane = lane_id_now(); F.tid = F.wave * 64 + F.lane; asm volatile("" : "+s"(F.G), "+s"(F.vcu));
    for (int ch = F.vcu; ch < NTOK / 128; ch += F.G) {
        const int t0 = ch * 128; const bool first = (ch % (SEQ / 128)) == 0;
        #ifndef MIX_MASK
#define MIX_MASK 15
#endif
        if (MIX_MASK & 1) mix_sgu(F, A, t0); if (MIX_MASK & 2) mix_attn(F, A, t0, first); if (MIX_MASK & 4) mix_conv3(F, A, t0, first); if (MIX_MASK & 8) mix_conv31(F, A, t0, first);
        if (ABL & 15) { __syncthreads(); for (int idx = F.tid; idx < 128 * 128; idx += NTHREADS) { const int r = idx >> 7, c8 = (idx & 127) * 8, br = c8 >> 8;
            if ((ABL >> br) & 1) *(u32x4*)(A.ys + (size_t)(t0 + r) * 1024 + c8) = (u32x4){0u, 0u, 0u, 0u}; } }
    }
}

struct RouteArgs { const float* x1; const float* g2; const float *wgrp, *bgrp, *wexp, *bexp; float* rs; int* bkt; float *wlo, *whi; int* slot_tok; unsigned* counts; };
__device__ __forceinline__ void router_phase(const Frame& F0, const RouteArgs& R) {
    Frame F = F0; F.lane = lane_id_now(); F.tid = F.wave * 64 + F.lane; asm volatile("" : "+s"(F.G), "+s"(F.vcu));
    LAS float* Wr = (LAS float*)F.lds;
    LAS unsigned* hist = (LAS unsigned*)(F.lds + 20 * 1024 * 4);
    for (int idx = F.tid; idx < 1024 * 4; idx += NTHREADS) Wr[(idx & 3) * 1024 + (idx >> 2)] = R.wgrp[idx];
    for (int idx = F.tid; idx < 1024 * 16; idx += NTHREADS) Wr[(4 + (idx & 15)) * 1024 + (idx >> 4)] = R.wexp[idx];
    if (F.tid < 32) hist[F.tid] = 0u;
    { const int gt = F.vcu * NTHREADS + F.tid, NGT = F.G * NTHREADS; for (int idx = gt; idx < MPAD_MAX; idx += NGT) R.slot_tok[idx] = -1; }
    __syncthreads();
    f32x4 gv[4];
#pragma unroll
    for (int j = 0; j < 4; ++j) gv[j] = *((const f32x4*)R.g2 + F.lane + 64 * j);
    const int gw = F.vcu * NWAVES + F.wave, NGW = F.G * NWAVES;
    for (int grp = gw; grp < NTOK / 16; grp += NGW)
        for (int i = 0; i < 16; ++i) {
            const int tok = grp * 16 + i;
            const f32x4* xr = (const f32x4*)(R.x1 + (size_t)tok * D) + F.lane;
            f32x4 v[4]; float s = 0.f;
#pragma unroll
            for (int j = 0; j < 4; ++j) { v[j] = xr[64 * j]; s += (v[j][0] * v[j][0] + v[j][1] * v[j][1]) + (v[j][2] * v[j][2] + v[j][3] * v[j][3]); }
            const float rs = 1.0f / sqrtf(wave_sum(s) * (1.0f / D) + EPS);
#pragma unroll
            for (int j = 0; j < 4; ++j) v[j] = v[j] * rs * gv[j];
            float lg[20];
#pragma unroll
            for (int c = 0; c < 20; ++c) { float a = 0.f;
#pragma unroll
                for (int j = 0; j < 4; ++j) { const f32x4 w = *((const LAS f32x4*)(Wr + c * 1024) + F.lane + 64 * j); a += (v[j][0] * w[0] + v[j][1] * w[1]) + (v[j][2] * w[2] + v[j][3] * w[3]); }
                lg[c] = wave_sum(a); }
            float gl[4]; int gi = 0;
#pragma unroll
            for (int k = 0; k < 4; ++k) gl[k] = lg[k] + R.bgrp[k];
            float gm = gl[0];
#pragma unroll
            for (int k = 1; k < 4; ++k) if (gl[k] > gm) { gm = gl[k]; gi = k; }
            float den = 0.f;
#pragma unroll
            for (int k = 0; k < 4; ++k) den += expf(gl[k] - gm);
            const float gwt = 1.0f / den;
            float el[4];
#pragma unroll
            for (int k = 0; k < 4; ++k) { const float a0 = lg[4 + k], a1 = lg[8 + k], a2 = lg[12 + k], a3 = lg[16 + k];
                el[k] = (gi == 0 ? a0 : gi == 1 ? a1 : gi == 2 ? a2 : a3) + R.bexp[gi * 4 + k]; }
            int i1 = 0; float v1 = el[0];
#pragma unroll
            for (int k = 1; k < 4; ++k) if (el[k] > v1) { v1 = el[k]; i1 = k; }
            int i2 = -1; float v2 = 0.f;
#pragma unroll
            for (int k = 0; k < 4; ++k) if (k != i1 && (i2 < 0 || el[k] > v2)) { v2 = el[k]; i2 = k; }
            const float e2 = expf(v2 - v1), tw1 = gwt / (1.0f + e2), tw2 = gwt * e2 / (1.0f + e2);
            const int lo = i1 < i2 ? i1 : i2, hi = i1 < i2 ? i2 : i1;
            const int pr = lo == 0 ? hi - 1 : (lo == 1 ? hi + 1 : 5);
            const int bucket = gi * 6 + pr;
            if (F.lane == 0) { R.rs[tok] = rs; R.bkt[tok] = bucket; R.wlo[tok] = i1 < i2 ? tw1 : tw2; R.whi[tok] = i1 < i2 ? tw2 : tw1; __hip_atomic_fetch_add(&hist[bucket], 1u, __ATOMIC_RELAXED, __HIP_MEMORY_SCOPE_WORKGROUP); }
        }
    __syncthreads();
    if (F.tid < NBUCKET && hist[F.tid]) xb_add(R.counts + F.tid, hist[F.tid]);
    __syncthreads();
}
struct SlotArgs { const float* x1; const float* g2; const float* rs; const int* bkt; const float *wlo, *whi; int* slot_tok; float* slot_w; bf16_t* h2s; unsigned* counts; unsigned* cursor; unsigned* ntiles; unsigned* tile_bucket; };
__device__ __forceinline__ void slot_phase(const Frame& F0, const SlotArgs& S) {
    Frame F = F0; F.lane = lane_id_now(); F.tid = F.wave * 64 + F.lane; asm volatile("" : "+s"(F.G), "+s"(F.vcu));
    LAS int* offs = (LAS int*)F.lds;
    LAS unsigned* lcnt = (LAS unsigned*)(F.lds + 128);
    LAS unsigned* base = (LAS unsigned*)(F.lds + 256);
    if (F.tid == 0) { int off = 0; for (int b = 0; b < NBUCKET; ++b) { const int c = (int)xb_ld(S.counts + b); offs[b] = off; off += (c + 255) & ~255; } offs[NBUCKET] = off; }
    __syncthreads();
    const int nT = offs[NBUCKET] >> 8;
    if (blockIdx.x == 0) {
        if (F.tid == 0) __hip_atomic_store(S.ntiles, (unsigned)nT, __ATOMIC_RELAXED, __HIP_MEMORY_SCOPE_AGENT);
        if (F.tid < nT) { int tb = 0; for (int b = 0; b < NBUCKET; ++b) if (F.tid * 256 >= offs[b] && F.tid * 256 < offs[b + 1]) tb = b;
            __hip_atomic_store(S.tile_bucket + F.tid, (unsigned)tb, __ATOMIC_RELAXED, __HIP_MEMORY_SCOPE_AGENT); }
    }
    f32x4 gv[4];
#pragma unroll
    for (int j = 0; j < 4; ++j) gv[j] = *((const f32x4*)S.g2 + F.lane + 64 * j);
    for (int tb = F.vcu; tb < NTOK / 128; tb += F.G) {
        if (F.tid < NBUCKET) lcnt[F.tid] = 0u;
        __syncthreads();
        const int tokl = tb * 128 + F.wave * 16 + (F.lane & 15);
        int bk = 0; unsigned rank = 0; float rsv = 0.f;
        if (F.lane < 16) { bk = S.bkt[tokl]; rsv = S.rs[tokl]; rank = __hip_atomic_fetch_add(&lcnt[bk], 1u, __ATOMIC_RELAXED, __HIP_MEMORY_SCOPE_WORKGROUP); }
        __syncthreads();
        if (F.tid < NBUCKET) base[F.tid] = lcnt[F.tid] ? xb_add(S.cursor + F.tid, lcnt[F.tid]) : 0u;
        __syncthreads();
        int slot = 0;
        if (F.lane < 16) { slot = offs[bk] + (int)base[bk] + (int)rank; S.slot_tok[slot] = tokl; S.slot_w[slot * 2] = S.wlo[tokl]; S.slot_w[slot * 2 + 1] = S.whi[tokl]; }
#pragma unroll
        for (int i = 0; i < 16; ++i) {
            const int si = __builtin_amdgcn_readlane(slot, i); const float rs = __int_as_float(__builtin_amdgcn_readlane(__float_as_int(rsv), i));
            const f32x4* xr = (const f32x4*)(S.x1 + (size_t)(tb * 128 + F.wave * 16 + i) * D) + F.lane;
            u32x2* o8 = (u32x2*)(S.h2s + (size_t)si * D) + F.lane;
#pragma unroll
            for (int j = 0; j < 4; ++j) { const f32x4 y = xr[64 * j] * rs * gv[j]; u32x2 o; o.x = cvt_pk_bf16(y[0], y[1]); o.y = cvt_pk_bf16(y[2], y[3]); o8[64 * j] = o; }
        }
        __syncthreads();
    }
}

constexpr int N_PHASES = 1 + 10 * DEPTH;
#ifndef PH_MASK
#define PH_MASK 0x7ff
#endif
#define PHON(k) (((PH_MASK) >> (k)) & 1)
__global__ void __launch_bounds__(NTHREADS, 2) fwd(Args args) {
    extern __shared__ __attribute__((aligned(16))) unsigned char lds[];
    Frame F;
    F.lds = (LAS unsigned char*)lds; F.ws = args.ws; F.ctl = (unsigned*)(args.ws + WS_CTL);
    F.wave = __builtin_amdgcn_readfirstlane((int)threadIdx.x >> 6); F.lane = 0; F.tid = 0;
    F.G = gridDim.x; { const int bx = blockIdx.x; F.vcu = (F.G % 8 == 0) ? (bx % 8) * (F.G / 8) + bx / 8 : bx; }
    volatile LAS unsigned* lctl = (volatile LAS unsigned*)(F.lds + LDSCTL_OFF);
    if (threadIdx.x < 64) lctl[threadIdx.x] = 0u;
    __syncthreads();
    const int lo = args.ph_lo, hi = args.ph_hi;
    XcdBarrier bar; bar.bar = F.ctl + CW_BAR; bar.x = 0; bar.st = lctl; bar.wave = F.wave;
    if (hi - lo > 1) bar = xcd_barrier_post(F.ctl + CW_BAR, lctl);
#define IN(k) (lo <= (k) && (k) < hi)
#define SEAM(k) do { if (IN(k) && IN((k) + 1)) xcd_barrier(bar); } while (0)
    unsigned char* ws = args.ws;
    const float* x0 = (const float*)args.in[I_X];
    bf16_t* Hb = (bf16_t*)(ws + WS_HM); bf16_t* Pb = (bf16_t*)(ws + WS_BIG); bf16_t* Gb = (bf16_t*)(ws + WS_BIG); bf16_t* Mg = (bf16_t*)(ws + WS_HM);
    bf16_t* Ys = (bf16_t*)(ws + WS_YS); float* X1 = (float*)(ws + BIG_X1); bf16_t* H2s = (bf16_t*)(ws + BIG_H2S); bf16_t* Hid = (bf16_t*)(ws + BIG_HID);
    float* aux_rs = (float*)(ws + AUX_RS); int* aux_bkt = (int*)(ws + AUX_BKT); float* aux_wlo = (float*)(ws + AUX_WLO); float* aux_whi = (float*)(ws + AUX_WHI);
    int* slot_tok = (int*)(ws + AUX_STOK); float* slot_w = (float*)(ws + AUX_SW); unsigned* tile_bucket = (unsigned*)(ws + AUX_TB);

    if (PHON(0) && IN(0)) { p0_weights(F, args); norm_rows(F, x0, (const float*)args.in[I_N1G], Hb); }
    SEAM(0);
    for (int l = 0; l < DEPTH; ++l) {
        const int pb = 1 + 10 * l;
        const float* xin = (l == 0) ? x0 : (const float*)args.out;
        unsigned char* wl = ws + WS_W + (size_t)l * W_LAYER;
        unsigned* counts = F.ctl + CW_CNT + 64 * l; unsigned* cursor = counts + 32; unsigned* ntiles = counts + 60;
        if (PHON(1) && IN(pb + 0) && l > 0) norm_rows(F, xin, (const float*)args.in[I_N1G] + (size_t)l * D, Hb);
        if (l > 0) SEAM(pb + 0);
        if (PHON(2) && IN(pb + 1)) {
            PlainOrder S{(const char*)Hb, (const char*)(wl + W_IN), 128, 9, F.G, (int)blockIdx.x, (size_t)256 * D * 2, (size_t)256 * D * 2};
            EpiInProj E{Pb, (const float*)(ws + WS_ROPE), (const float*)args.in[I_QNG] + l * 64, (const float*)args.in[I_KNG] + l * 64};
            pg8::gemm_phase<EpiInProj, PlainOrder>(F.lds, F.wave, D, D, D, S, E);
        }
        SEAM(pb + 1);
        if (PHON(3) && IN(pb + 2)) {
            MixArgs A{Pb, Ys, (const float*)args.in[I_SLNG] + l * 256, (const float*)args.in[I_SLNB] + l * 256, (const float*)args.in[I_SGUW] + (size_t)l * 4 * 128 * 128, (const float*)args.in[I_SGUB] + l * 4 * 128,
                      (const float*)args.in[I_SINK] + l * 4, (const float*)args.in[I_C3W] + l * 3 * 256, (const float*)args.in[I_C31W] + l * 31 * 256, (const float*)args.in[I_C31B] + l * 256,
                      (const float*)args.in[I_CNG] + l * 256, (const float*)args.in[I_CNB] + l * 256};
            mixer_phase(F, A);
        }
        SEAM(pb + 2);
        if (PHON(4) && IN(pb + 3)) {
            PlainOrder S{(const char*)Hb, (const char*)(wl + W_GATE), 128, 16, F.G, (int)blockIdx.x, (size_t)256 * D * 2, (size_t)256 * D * 2};
            EpiGate E{Gb, (const float*)args.in[I_BGATE] + (size_t)l * 4096};
            pg8::gemm_phase<EpiGate, PlainOrder>(F.lds, F.wave, D, D, D, S, E);
        }
        SEAM(pb + 3);
        if (PHON(5) && IN(pb + 4)) {
            BranchOrder S{(const char*)Ys, (const char*)(wl + W_BR), F.G, (int)blockIdx.x};
            EpiMerge E{Gb, Mg};
            pg8::gemm_phase<EpiMerge, BranchOrder>(F.lds, F.wave, 256, D, 256, S, E);
        }
        SEAM(pb + 4);
        if (PHON(6) && IN(pb + 5)) {
            PlainOrder S{(const char*)Mg, (const char*)(wl + W_O), 128, 4, F.G, (int)blockIdx.x, (size_t)256 * D * 2, (size_t)256 * D * 2};
            EpiWo E{xin, X1};
            pg8::gemm_phase<EpiWo, PlainOrder>(F.lds, F.wave, D, D, D, S, E);
        }
        SEAM(pb + 5);
        if (PHON(7) && IN(pb + 6)) {
            RouteArgs R{X1, (const float*)args.in[I_N2G] + (size_t)l * D, (const float*)args.in[I_WGRP] + (size_t)l * D * 4, (const float*)args.in[I_BGRP] + l * 4,
                        (const float*)args.in[I_WEXP] + (size_t)l * D * 16, (const float*)args.in[I_BEXP] + l * 16, aux_rs, aux_bkt, aux_wlo, aux_whi, slot_tok, counts};
            router_phase(F, R);
        }
        SEAM(pb + 6);
        if (PHON(8) && IN(pb + 7)) {
            SlotArgs S{X1, (const float*)args.in[I_N2G] + (size_t)l * D, aux_rs, aux_bkt, aux_wlo, aux_whi, slot_tok, slot_w, H2s, counts, cursor, ntiles, tile_bucket};
            slot_phase(F, S);
        }
        SEAM(pb + 7);
        if (PHON(9) && IN(pb + 8)) {
            const int nT = __builtin_amdgcn_readfirstlane((int)xb_ld(ntiles));
            MoeUpOrder S{(const char*)H2s, (const char*)(wl + W_GU), tile_bucket, nT, F.G, F.vcu};
            EpiMoeUp E{Hid, slot_w};
            pg8::gemm_phase<EpiMoeUp, MoeUpOrder>(F.lds, F.wave, D, D, D, S, E);
        }
        SEAM(pb + 8);
        if (PHON(10) && IN(pb + 9)) {
            const int nT = __builtin_amdgcn_readfirstlane((int)xb_ld(ntiles));
            MoeDownOrder S{(const char*)Hid, (const char*)(wl + W_DN), tile_bucket, nT, F.G, F.vcu};
            EpiMoeDown E{slot_tok, X1, args.out};
            pg8::gemm_phase<EpiMoeDown, MoeDownOrder>(F.lds, F.wave, 512, 512, 256, S, E);
        }
        if (l + 1 < DEPTH) SEAM(pb + 9);
    }
#undef IN
#undef SEAM
}

extern "C" void kernel_launch(void* const* d_in, const int* in_sizes, int n_in, void* d_out, int out_size, void* d_ws, size_t ws_size, hipStream_t stream) {
    static int grid = 0;
    if (grid == 0) {
        if (n_in != N_IN || out_size != NTOK * D || ws_size < WS_END) { fprintf(stderr, "kernel_launch: unexpected shapes (n_in %d, out %d, ws %zu); nothing launched\n", n_in, out_size, ws_size); grid = -1; return; }
        int dev = 0, cus = 0, per_cu = 0;
        if (hipGetDevice(&dev) != hipSuccess || hipDeviceGetAttribute(&cus, hipDeviceAttributeMultiprocessorCount, dev) != hipSuccess) { grid = -1; return; }
        if (hipFuncSetAttribute((const void*)fwd, hipFuncAttributeMaxDynamicSharedMemorySize, LDS_BYTES) != hipSuccess) { fprintf(stderr, "kernel_launch: hipFuncSetAttribute failed\n"); grid = -1; return; }
        if (hipOccupancyMaxActiveBlocksPerMultiprocessor(&per_cu, (const void*)fwd, NTHREADS, LDS_BYTES) != hipSuccess || per_cu < 1)
            fprintf(stderr, "kernel_launch: note: occupancy query reports %d workgroups per CU\n", per_cu);
        (void)hipGetLastError();
        grid = cus;
    }
    if (grid < 0) return;
    (void)hipMemsetAsync((char*)d_ws + WS_CTL, 0, CTL_ZERO_BYTES, stream);
    Args a{};
    for (int i = 0; i < N_IN; ++i) a.in[i] = d_in[i];
    a.out = (float*)d_out; a.ws = (unsigned char*)d_ws;
#if MK_PER_PHASE
    for (int p = 0; p < N_PHASES; ++p) { if (p == 1) continue; a.ph_lo = p; a.ph_hi = p + 1; hipLaunchKernelGGL(fwd, dim3(grid), dim3(NTHREADS), LDS_BYTES, stream, a); }
#else
    a.ph_lo = 0; a.ph_hi = N_PHASES;
    hipLaunchKernelGGL(fwd, dim3(grid), dim3(NTHREADS), LDS_BYTES, stream, a);
#endif
}
```

```cpp
#include <hip/hip_runtime.h>
#include <cstdio>
#include <cstdint>

#ifndef ABL
#define ABL 0
#endif
#ifndef MK_PER_PHASE
#define MK_PER_PHASE 0
#endif

#define LAS __attribute__((address_space(3)))
#define GAS __attribute__((address_space(1)))
typedef unsigned short bf16_t;
typedef short bf16x8 __attribute__((ext_vector_type(8)));
typedef float f32x4 __attribute__((ext_vector_type(4)));
typedef float f32x2 __attribute__((ext_vector_type(2)));
typedef unsigned u32x4 __attribute__((ext_vector_type(4)));
typedef unsigned u32x2 __attribute__((ext_vector_type(2)));

constexpr int NB = 8, SEQ = 4096, D = 1024, NTOK = NB * SEQ, DEPTH = 2;
constexpr int DIN = 2304, PS = 1792;
constexpr int P_U = 0, P_GV = 256, P_Q = 512, P_K = 768, P_V = 896, P_BX = 1024, P_CC = 1280, P_GLU = 1536;
constexpr int NEXP = 16, DEXP = 256, NBUCKET = 24;
constexpr int MPAD_MAX = NTOK + NBUCKET * 256;
constexpr float EPS = 1e-6f;

typedef __bf16 bf16x2_t __attribute__((ext_vector_type(2)));
__device__ __forceinline__ unsigned cvt_pk_bf16(float lo, float hi) { const bf16x2_t v = {(__bf16)lo, (__bf16)hi}; return __builtin_bit_cast(unsigned, v); }
__device__ __forceinline__ float bf_lo(unsigned w) { return __uint_as_float(w << 16); }
__device__ __forceinline__ float bf_hi(unsigned w) { return __uint_as_float(w & 0xffff0000u); }
__device__ __forceinline__ float bf2f(bf16_t h) { return __uint_as_float(((unsigned)h) << 16); }
__device__ __forceinline__ float sigmoid_f(float x) { return __builtin_amdgcn_rcpf(1.0f + __builtin_amdgcn_exp2f(-1.44269504089f * x)); }
__device__ __forceinline__ float gelu_tanh_f(float x) {
    const float t = x * (1.0f + 0.044715f * x * x); return x * sigmoid_f(1.5957691216f * t); }
__device__ __forceinline__ float silu_f(float x) { return x * sigmoid_f(x); }

__device__ __forceinline__ int lane_id_now() { int l; asm volatile("v_mbcnt_lo_u32_b32 %0, -1, 0\n\tv_mbcnt_hi_u32_b32 %0, -1, %0" : "=v"(l)); return l; }
template <int CTRL> __device__ __forceinline__ float dpp_f(float v) { return __int_as_float(__builtin_amdgcn_mov_dpp(__float_as_int(v), CTRL, 0xf, 0xf, true)); }
__device__ __forceinline__ float xor16_f(float v) { return __int_as_float(__builtin_amdgcn_ds_swizzle(__float_as_int(v), 0x401F)); }
__device__ __forceinline__ float sum_xor32_f(float v) { const auto r = __builtin_amdgcn_permlane32_swap(__float_as_uint(v), __float_as_uint(v), false, false); return __uint_as_float(r[0]) + __uint_as_float(r[1]); }
__device__ __forceinline__ float wave_sum(float v) {
    v += dpp_f<0xB1>(v); v += dpp_f<0x4E>(v); v += dpp_f<0x141>(v); v += dpp_f<0x140>(v);
    v += xor16_f(v); return sum_xor32_f(v);
}

namespace pg8 {
constexpr int BM = 256, BK = 64, HALF = 128, HTB = HALF * BK * 2  , STAGE_BYTES = 8 * HTB, NXCD = 8, WGM = 8;
__host__ __device__ __forceinline__ int lds_byte(int r, int c) { const int st = (r >> 4) * 2 + (c >> 5), rr = r & 15, cc = c & 31, ob = rr * 64 + cc * 2; return st * 1024 + (ob ^ (((ob >> 9) & 1) << 5)); }
__host__ __device__ __forceinline__ void stage_rc(int b, int& R, int& C) { const int st = b / 1024, sb = b % 1024, swz = sb ^ (((sb >> 9) & 1) << 5); R = (st >> 1) * 16 + swz / 64; C = (st & 1) * 32 + (swz % 64) / 2; }
__host__ __device__ __forceinline__ int perm32(int rho) { const int n = rho >> 4, i = rho & 15; return 8 * (i >> 2) + 4 * n + (i & 3); }

struct Unit { int pm, pn, aux; };

__device__ __forceinline__ void tile_of(int L, int nM, int nN, int& pm, int& pn) {
    const int nwg = nM * nN; int wgid = L; { const int q = nwg / NXCD, r = nwg % NXCD, xcd = wgid % NXCD, off = wgid / NXCD; wgid = (xcd < r ? xcd * (q + 1) : r * (q + 1) + (xcd - r) * q) + off; }
    const int nig = WGM * nN, gid = wgid / nig, fm = gid * WGM, gsz = (nM - fm) < WGM ? (nM - fm) : WGM;
    pm = fm + ((wgid % nig) % gsz); pn = (wgid % nig) / gsz;
}

template <class Epi, class Sched>
__device__ __forceinline__ void gemm_phase(LAS unsigned char* lds, const int wid  , const int K, const int lda, const int ldb, const Sched& S, const Epi& E) {
    const int lane = lane_id_now(), tid = wid * 64 + lane;
    const int wr = wid >> 2, wc = wid & 3, fr = lane & 15, fq = lane >> 4;
    int nt = K / BK; asm volatile("" : "+s"(nt));
    unsigned voffA[2], voffB[2];
#pragma unroll
    for (int i = 0; i < 2; ++i) { int R, C; stage_rc(tid * 16 + i * 8192, R, C); const int Rb = Epi::PERM ? ((R & ~31) + perm32(R & 31)) : R;
        voffA[i] = (unsigned)(R * lda + C) * 2u; voffB[i] = (unsigned)(Rb * ldb + C) * 2u; }
    asm volatile("" : "+v"(voffA[0]), "+v"(voffA[1]), "+v"(voffB[0]), "+v"(voffB[1]));
    const size_t kstep = (size_t)(BK * 2);
    const size_t hstepA = (size_t)HALF * lda * 2, hstepB = (size_t)HALF * ldb * 2;
    const unsigned ldsw = (unsigned)wid * 1024u;
    const int aoff = lds_byte(wr * 64 + fr, fq * 8), boff = lds_byte(wc * 32 + fr, fq * 8);
#define PG8_SA(b, h) (((b) * 2 + (h)) * HTB)
#define PG8_SB(b, h) ((4 + (b) * 2 + (h)) * HTB)
#define PG8_STAGE(bufoff, gbase, voff) do { _Pragma("unroll") for (int _i = 0; _i < 2; ++_i) \
        __builtin_amdgcn_global_load_lds((const unsigned*)((const char*)(gbase) + (voff)[_i]), (LAS unsigned*)(lds + (bufoff) + ldsw + _i * 8192), 16, 0, 0); } while (0)
#define PG8_LDA(dst, b, h) do { _Pragma("unroll") for (int m = 0; m < 4; ++m) _Pragma("unroll") for (int k = 0; k < 2; ++k) dst[m][k] = *(const LAS bf16x8*)(lds + PG8_SA(b, h) + aoff + m * 2048 + k * 1024); } while (0)
#define PG8_LDB(dst, b, h) do { _Pragma("unroll") for (int n = 0; n < 2; ++n) _Pragma("unroll") for (int k = 0; k < 2; ++k) dst[n][k] = *(const LAS bf16x8*)(lds + PG8_SB(b, h) + boff + n * 2048 + k * 1024); } while (0)
#define PG8_MMA(ai, bj, At, Bt) do { __builtin_amdgcn_s_setprio(1); _Pragma("unroll") for (int m = 0; m < 4; ++m) _Pragma("unroll") for (int n = 0; n < 2; ++n) _Pragma("unroll") for (int k = 0; k < 2; ++k) \
        acc[ai][bj][m][n] = __builtin_amdgcn_mfma_f32_16x16x32_bf16(Bt[n][k], At[m][k], acc[ai][bj][m][n], 0, 0, 0); __builtin_amdgcn_s_setprio(0); } while (0)
#define PG8_WAIT_V(n) asm volatile("s_waitcnt vmcnt(" #n ")" ::: "memory")
#define PG8_WAIT_L(n) asm volatile("s_waitcnt lgkmcnt(" #n ")" ::: "memory")
#define PG8_BAR __builtin_amdgcn_s_barrier()
#define PG8_SCHED __builtin_amdgcn_sched_barrier(0)
    Unit cur, nxt; int ui = 0;
    if (!S.next(0, cur)) return;
    f32x4 acc[2][2][4][2];
#pragma unroll
    for (int a = 0; a < 2; ++a)
#pragma unroll
        for (int b = 0; b < 2; ++b)
#pragma unroll
            for (int m = 0; m < 4; ++m)
#pragma unroll
                for (int n = 0; n < 2; ++n) acc[a][b][m][n] = (f32x4){0.f, 0.f, 0.f, 0.f};
    bf16x8 At[4][2], B0[2][2], B1[2][2];
    const char* cA = S.a_ptr(cur); const char* cB = S.b_ptr(cur);
    PG8_STAGE(PG8_SB(0, 0), cB, voffB); PG8_STAGE(PG8_SB(0, 1), cB + hstepB, voffB); PG8_STAGE(PG8_SA(0, 0), cA, voffA); PG8_STAGE(PG8_SA(0, 1), cA + hstepA, voffA);
    if (wr == 1) PG8_BAR;
    PG8_WAIT_V(2); PG8_BAR;
    PG8_STAGE(PG8_SB(1, 0), cB + kstep, voffB); PG8_STAGE(PG8_SA(1, 0), cA + kstep, voffA); PG8_STAGE(PG8_SB(1, 1), cB + hstepB + kstep, voffB);
    PG8_WAIT_V(6); PG8_BAR;
    for (;;) {
        const bool has_next = S.next(ui + 1, nxt);
        const char* nA = has_next ? S.a_ptr(nxt) : cA; const char* nB = has_next ? S.b_ptr(nxt) : cB;
        const char* cB2 = cB; int segT = nt;
        if constexpr (Sched::TWO_SEG) { segT = S.seg_tiles(); cB2 = S.b_ptr2(cur) - (size_t)segT * kstep; }
        for (int t = 0; t < nt; t += 2) {
            const bool last = (t == nt - 2);
            const char* a1 = cA + (size_t)(t + 1) * kstep;
            const char* bsrc = (t + 2 >= segT) ? cB2 : cB;
            const char* a2 = last ? nA : cA + (size_t)(t + 2) * kstep; const char* b2 = last ? nB : bsrc + (size_t)(t + 2) * kstep;
            const char* a3 = a2 + kstep; const char* b3 = b2 + kstep;
            PG8_LDB(B0, 0, 0); PG8_LDB(B1, 0, 1); PG8_SCHED; PG8_LDA(At, 0, 0); PG8_STAGE(PG8_SA(1, 1), a1 + hstepA, voffA);
            PG8_WAIT_V(8); PG8_WAIT_L(0); PG8_BAR; PG8_MMA(0, 0, At, B0); PG8_MMA(0, 1, At, B1); PG8_BAR; PG8_SCHED;
            PG8_LDA(At, 0, 1); PG8_STAGE(PG8_SB(0, 0), b2, voffB); PG8_STAGE(PG8_SB(0, 1), b2 + hstepB, voffB); PG8_STAGE(PG8_SA(0, 0), a2, voffA);
            PG8_WAIT_V(8); PG8_WAIT_L(0); PG8_BAR; PG8_MMA(1, 0, At, B0); PG8_MMA(1, 1, At, B1); PG8_BAR; PG8_SCHED;
            PG8_LDB(B0, 1, 0); PG8_LDB(B1, 1, 1); PG8_SCHED; PG8_LDA(At, 1, 0); PG8_STAGE(PG8_SA(0, 1), a2 + hstepA, voffA);
            PG8_WAIT_V(8); PG8_WAIT_L(0); PG8_BAR; PG8_MMA(0, 0, At, B0); PG8_MMA(0, 1, At, B1); PG8_BAR; PG8_SCHED;
            PG8_LDA(At, 1, 1); PG8_STAGE(PG8_SB(1, 0), b3, voffB); PG8_STAGE(PG8_SB(1, 1), b3 + hstepB, voffB); PG8_STAGE(PG8_SA(1, 0), a3, voffA);
            PG8_WAIT_V(8); PG8_WAIT_L(0); PG8_BAR; PG8_MMA(1, 0, At, B0); PG8_MMA(1, 1, At, B1); PG8_BAR; PG8_SCHED;
        }
        if (wr == 0) PG8_BAR;
        { const int le = lane_id_now(); E(acc, cur, wr, wc, le & 15, le >> 4); }
        if (!has_next) break;
#pragma unroll
        for (int a = 0; a < 2; ++a)
#pragma unroll
            for (int b = 0; b < 2; ++b)
#pragma unroll
                for (int m = 0; m < 4; ++m)
#pragma unroll
                    for (int n = 0; n < 2; ++n) acc[a][b][m][n] = (f32x4){0.f, 0.f, 0.f, 0.f};
        cur = nxt; cA = nA; cB = nB; ++ui;
        if (wr == 1) PG8_BAR;
    }
    PG8_WAIT_V(0);
    PG8_BAR;
#undef PG8_SA
#undef PG8_SB
#undef PG8_STAGE
#undef PG8_LDA
#undef PG8_LDB
#undef PG8_MMA
#undef PG8_WAIT_V
#undef PG8_WAIT_L
#undef PG8_BAR
#undef PG8_SCHED
}
}

constexpr size_t MiB = 1u << 20;
constexpr size_t WS_CTL = 0, CTL_ZERO_BYTES = 1 * MiB;
constexpr size_t WS_AUX = 1 * MiB;
constexpr size_t AUX_RS = WS_AUX, AUX_BKT = AUX_RS + 131072, AUX_WLO = AUX_BKT + 131072, AUX_WHI = AUX_WLO + 131072,
                 AUX_STOK = AUX_WHI + 131072, AUX_SW = AUX_STOK + 163840, AUX_TB = AUX_SW + 327680;
constexpr size_t WS_ROPE = 2 * MiB;
constexpr size_t WS_W = 4 * MiB;
constexpr size_t W_IN = 0, W_GATE = W_IN + (size_t)DIN * D * 2, W_BR = W_GATE + (size_t)4096 * D * 2, W_O = W_BR + (size_t)4 * D * 256 * 2,
                 W_GU = W_O + (size_t)D * D * 2, W_DN = W_GU + (size_t)NEXP * 512 * D * 2, W_LAYER = W_DN + (size_t)NEXP * D * 256 * 2;
constexpr size_t WS_SGU = WS_W + 2 * W_LAYER;
constexpr size_t WS_BIG = 86 * MiB;
constexpr size_t BIG_X1 = WS_BIG, BIG_H2S = BIG_X1 + (size_t)NTOK * D * 4, BIG_HID = BIG_H2S + (size_t)MPAD_MAX * D * 2;
constexpr size_t WS_HM = 342 * MiB;
constexpr size_t WS_YS = 406 * MiB;
constexpr size_t WS_END = 470 * MiB;
static_assert(WS_SGU + 262144 <= WS_BIG && BIG_HID + (size_t)MPAD_MAX * 512 * 2 <= WS_HM && AUX_TB + 1024 <= WS_ROPE, "d_ws map");
constexpr int CW_BAR = 4096;
constexpr int CW_CNT = 8192;

constexpr int RING_BYTES = 131072;
constexpr int LDSCTL_OFF = RING_BYTES;
constexpr int LDS_BYTES = 147456;
constexpr int NWAVES = 8, NTHREADS = 512;

#define XB_TMO      128
#define XB_XCNT(j)  (256  + 64 * (j))
#define XB_XSUB(j)  (1280 + 64 * (j))
#define XB_XGEN(j)  (2304 + 64 * (j))
#define XB_TOP      3328
#define XB_TOPGEN   3392
#define XCD_BAR_WORDS 3456
#define XB_SPIN_CAP (1u << 18)

__device__ __forceinline__ unsigned xb_ld(unsigned* p)              { return __hip_atomic_load(p, __ATOMIC_RELAXED, __HIP_MEMORY_SCOPE_AGENT); }
__device__ __forceinline__ unsigned xb_add(unsigned* p, unsigned v) { return __hip_atomic_fetch_add(p, v, __ATOMIC_RELAXED, __HIP_MEMORY_SCOPE_AGENT); }
__device__ __forceinline__ unsigned xb_xcc_id() { return (unsigned)__builtin_amdgcn_s_getreg((3 << 11) | 20) & 0xFu; }
#define XB_SPIN(cond, bar) do { unsigned _sp = 0; while (cond) { __builtin_amdgcn_s_sleep(1); \
    if ((++_sp & 255u) == 0u) { if (xb_ld(&(bar)[XB_TMO])) break; if (_sp > XB_SPIN_CAP) { atomicAdd(&(bar)[XB_TMO], 1u); break; } } } } while (0)

struct XcdBarrier {
    unsigned* bar; unsigned x; int wave;
    volatile LAS unsigned* st;
};
__device__ __forceinline__ XcdBarrier xcd_barrier_post(unsigned* bar, volatile LAS unsigned* st) {
    XcdBarrier b; b.bar = bar; b.x = xb_xcc_id(); b.st = st; b.wave = __builtin_amdgcn_readfirstlane((int)threadIdx.x >> 6);
    if (threadIdx.x == 0) (void)xb_add(&bar[XB_XCNT(b.x)], 1u);
    return b;
}
__device__ __forceinline__ void xcd_barrier_complete(unsigned* bar, unsigned x, unsigned& nloc, unsigned& nx) {
    const unsigned G = gridDim.x * gridDim.y * gridDim.z;
    unsigned sum, cnt, mine, sp = 0u;
    for (;;) {
        sum = 0u; cnt = 0u; mine = 0u;
#pragma unroll
        for (unsigned j = 0; j < 16; ++j) { const unsigned c = xb_ld(&bar[XB_XCNT(j)]); sum += c; cnt += (c > 0u) ? 1u : 0u; mine = (j == x) ? c : mine; }
        if (sum == G) break;
        __builtin_amdgcn_s_sleep(1);
        if ((++sp & 255u) == 0u) { if (xb_ld(&bar[XB_TMO])) break; if (sp > XB_SPIN_CAP) { atomicAdd(&bar[XB_TMO], 1u); break; } }
    }
    nloc = mine > 0u ? mine : 1u; nx = cnt > 0u ? cnt : 1u;
}
__device__ __forceinline__ void xcd_barrier(const XcdBarrier& b) {
    asm volatile("s_waitcnt vmcnt(0)" ::: "memory");
    __syncthreads();
    if (b.wave == 0 && lane_id_now() == 0) {
        unsigned* bar = b.bar;
        __builtin_amdgcn_s_waitcnt(0);
        unsigned nloc = b.st[0], nx = b.st[1];
        if (nloc == 0u) { xcd_barrier_complete(bar, b.x, nloc, nx); b.st[0] = nloc; b.st[1] = nx; }
        const unsigned old = xb_add(&bar[XB_XSUB(b.x)], 1u);
        const unsigned gen = old / nloc;
        if (old + 1u == (gen + 1u) * nloc) {
            __builtin_amdgcn_fence(__ATOMIC_RELEASE, "agent");
            asm volatile("s_waitcnt vmcnt(0)" ::: "memory");
            const unsigned og = xb_add(&bar[XB_TOP], 1u);
            const unsigned tg = og / nx;
            if (og + 1u == (tg + 1u) * nx) xb_add(&bar[XB_TOPGEN], 1u);
            else XB_SPIN(xb_ld(&bar[XB_TOPGEN]) == tg, bar);
            __builtin_amdgcn_fence(__ATOMIC_ACQUIRE, "agent");
            xb_add(&bar[XB_XGEN(b.x)], 1u);
            asm volatile("s_waitcnt vmcnt(0)" ::: "memory");
        } else {
            XB_SPIN(xb_ld(&bar[XB_XGEN(b.x)]) == gen, bar);
            __builtin_amdgcn_fence(__ATOMIC_ACQUIRE, "agent");
            asm volatile("s_waitcnt vmcnt(0)" ::: "memory");
        }
    }
    __syncthreads();
}

struct PlainOrder {
    static constexpr bool TWO_SEG = false;
    const char* A; const char* Bt; int nM, nN, G, c; size_t tA, tB;
    __device__ __forceinline__ bool next(int i, pg8::Unit& u) const { const int L = i * G + c; if (L >= nM * nN) return false; pg8::tile_of(L, nM, nN, u.pm, u.pn); u.aux = 0; return true; }
    __device__ __forceinline__ const char* a_ptr(const pg8::Unit& u) const { return A + (size_t)u.pm * tA; }
    __device__ __forceinline__ const char* b_ptr(const pg8::Unit& u) const { return Bt + (size_t)u.pn * tB; }
};
struct BranchOrder {
    static constexpr bool TWO_SEG = false;
    const char* ys; const char* wb; int G, c;
    __device__ __forceinline__ bool next(int i, pg8::Unit& u) const { const int L = (i >> 2) * G + c; if (L >= 128 * 4) return false; pg8::tile_of(L, 128, 4, u.pm, u.pn); u.aux = i & 3; return true; }
    __device__ __forceinline__ const char* a_ptr(const pg8::Unit& u) const { return ys + (size_t)u.pm * (256 * 1024 * 2) + (size_t)u.aux * 512; }
    __device__ __forceinline__ const char* b_ptr(const pg8::Unit& u) const { return wb + (size_t)(u.aux * 1024 + u.pn * 256) * 512; }
};
__device__ __forceinline__ void bucket_experts(int bucket, int& e1, int& e2) {
    const int g = bucket / 6, pr = bucket - 6 * g;
    const int a = pr < 3 ? 0 : (pr < 5 ? 1 : 2), b = pr < 3 ? pr + 1 : (pr < 5 ? pr - 1 : 3);
    e1 = 4 * g + a; e2 = 4 * g + b;
}
struct MoeUpOrder {
    static constexpr bool TWO_SEG = false;
    const char* h2s; const char* wgu; unsigned* tile_bucket; int nTiles, G, vcu;
    __device__ __forceinline__ bool next(int i, pg8::Unit& u) const { const int L = i * G + vcu; if (L >= nTiles * 4) return false; u.pm = L >> 2; u.pn = L & 3;
        u.aux = __builtin_amdgcn_readfirstlane((int)__hip_atomic_load(tile_bucket + u.pm, __ATOMIC_RELAXED, __HIP_MEMORY_SCOPE_AGENT)); return true; }
    __device__ __forceinline__ const char* a_ptr(const pg8::Unit& u) const { return h2s + (size_t)u.pm * (256 * 1024 * 2); }
    __device__ __forceinline__ const char* b_ptr(const pg8::Unit& u) const { int e1, e2; bucket_experts(u.aux, e1, e2); const int e = u.pn < 2 ? e1 : e2; return wgu + (size_t)(e * 512 + (u.pn & 1) * 256) * 2048; }
};
struct MoeDownOrder {
    static constexpr bool TWO_SEG = true;
    const char* hid; const char* wdn; unsigned* tile_bucket; int nTiles, G, vcu;
    __device__ __forceinline__ bool next(int i, pg8::Unit& u) const { const int L = i * G + vcu; if (L >= nTiles * 4) return false; u.pm = L >> 2; u.pn = L & 3;
        u.aux = __builtin_amdgcn_readfirstlane((int)__hip_atomic_load(tile_bucket + u.pm, __ATOMIC_RELAXED, __HIP_MEMORY_SCOPE_AGENT)); return true; }
    __device__ __forceinline__ int seg_tiles() const { return 4; }
    __device__ __forceinline__ const char* a_ptr(const pg8::Unit& u) const { return hid + (size_t)u.pm * (256 * 512 * 2); }
    __device__ __forceinline__ const char* b_ptr(const pg8::Unit& u) const { int e1, e2; bucket_experts(u.aux, e1, e2); return wdn + (size_t)(e1 * 1024 + u.pn * 256) * 512; }
    __device__ __forceinline__ const char* b_ptr2(const pg8::Unit& u) const { int e1, e2; bucket_experts(u.aux, e1, e2); return wdn + (size_t)(e2 * 1024 + u.pn * 256) * 512; }
};

typedef f32x4 Acc[2][2][4][2];
__device__ __forceinline__ u32x4 pack8(const f32x4 a, const f32x4 b) { u32x4 w; w.x = cvt_pk_bf16(a[0], a[1]); w.y = cvt_pk_bf16(a[2], a[3]); w.z = cvt_pk_bf16(b[0], b[1]); w.w = cvt_pk_bf16(b[2], b[3]); return w; }
__device__ __forceinline__ void unpack8(const u32x4 w, f32x4& a, f32x4& b) { a = (f32x4){bf_lo(w.x), bf_hi(w.x), bf_lo(w.y), bf_hi(w.y)}; b = (f32x4){bf_lo(w.z), bf_hi(w.z), bf_lo(w.w), bf_hi(w.w)}; }

struct EpiInProj {
    static constexpr bool PERM = true;
    bf16_t* P; const float* rope; const float* qg; const float* kg;
    __device__ __forceinline__ void operator()(const Acc& acc, const pg8::Unit& u, int wr, int wc, int fr, int fq) const {
        asm volatile("" : "+v"(fr), "+v"(fq));
        const int pn = u.pn, row0 = u.pm * 256 + wr * 64 + fr, c8 = wc * 32 + 8 * fq;
        if (pn == 2 || (pn == 3 && wc < 2)) {
            const float* gp = (pn == 2) ? qg : kg; const float osc = (pn == 2) ? 0.125f : 1.0f;
            f32x4 g[2][2];
#pragma unroll
            for (int bj = 0; bj < 2; ++bj)
#pragma unroll
                for (int n = 0; n < 2; ++n) g[bj][n] = *(const f32x4*)(gp + bj * 32 + 8 * fq + 4 * n);
            const int dcol = (pn == 2 ? P_Q : P_K) + wc * 64 + 8 * fq;
#pragma unroll
            for (int ai = 0; ai < 2; ++ai)
#pragma unroll
                for (int m = 0; m < 4; ++m) {
                    const int row = row0 + ai * 128 + m * 16;
                    float ss = 0.f;
#pragma unroll
                    for (int bj = 0; bj < 2; ++bj)
#pragma unroll
                        for (int n = 0; n < 2; ++n) { const f32x4 v = acc[ai][bj][m][n]; ss += (v[0] * v[0] + v[1] * v[1]) + (v[2] * v[2] + v[3] * v[3]); }
                    ss += xor16_f(ss); ss = sum_xor32_f(ss);
                    const float rs = __builtin_amdgcn_rsqf(ss * (1.0f / 64.0f) + EPS);
                    f32x4 o[2][2];
#pragma unroll
                    for (int bj = 0; bj < 2; ++bj)
#pragma unroll
                        for (int n = 0; n < 2; ++n) o[bj][n] = acc[ai][bj][m][n] * rs * g[bj][n];
                    const float* rp = rope + (size_t)row * 16;
#pragma unroll
                    for (int n = 0; n < 2; ++n) {
                        const f32x4 cs = *(const f32x4*)(rp + 4 * n), sn = *(const f32x4*)(rp + 8 + 4 * n);
                        f32x4 other;
#pragma unroll
                        for (int j = 0; j < 4; ++j) other[j] = xor16_f(o[0][n][j]);
                        const f32x4 rot = (fq == 0) ? (o[0][n] * cs - other * sn) : (o[0][n] * cs + other * sn);
                        if (fq < 2) o[0][n] = rot;
                    }
#pragma unroll
                    for (int bj = 0; bj < 2; ++bj) *(u32x4*)(P + (size_t)row * PS + dcol + bj * 32) = pack8(o[bj][0] * osc, o[bj][1] * osc);
                }
            return;
        }
#pragma unroll
        for (int ai = 0; ai < 2; ++ai)
#pragma unroll
            for (int m = 0; m < 4; ++m) {
                bf16_t* prow = P + (size_t)(row0 + ai * 128 + m * 16) * PS;
                const f32x4 a0 = acc[ai][0][m][0], a1 = acc[ai][0][m][1], b0 = acc[ai][1][m][0], b1 = acc[ai][1][m][1];
                if (pn < 2) {
                    f32x4 x0, x1, y0, y1;
#pragma unroll
                    for (int j = 0; j < 4; ++j) { x0[j] = gelu_tanh_f(a0[j]); x1[j] = gelu_tanh_f(a1[j]); y0[j] = gelu_tanh_f(b0[j]); y1[j] = gelu_tanh_f(b1[j]); }
                    *(u32x4*)(prow + pn * 256 + c8) = pack8(x0, x1); *(u32x4*)(prow + pn * 256 + 128 + c8) = pack8(y0, y1);
                } else if (pn == 3) {
                    const int dc = P_V + (wc - 2) * 64 + 8 * fq;
                    *(u32x4*)(prow + dc) = pack8(a0, a1); *(u32x4*)(prow + dc + 32) = pack8(b0, b1);
                } else if (pn == 4 || pn == 5) {
                    *(u32x4*)(prow + P_BX + (pn - 4) * 128 + c8) = pack8(a0 * b0, a1 * b1);
                } else if (pn == 6) {
                    *(u32x4*)(prow + P_CC + c8) = pack8(a0, a1); *(u32x4*)(prow + P_CC + 128 + c8) = pack8(b0, b1);
                } else {
                    f32x4 x0, x1;
#pragma unroll
                    for (int j = 0; j < 4; ++j) { x0[j] = a0[j] * sigmoid_f(b0[j]); x1[j] = a1[j] * sigmoid_f(b1[j]); }
                    *(u32x4*)(prow + P_GLU + (pn - 7) * 128 + c8) = pack8(x0, x1);
                }
            }
    }
};
struct EpiGate {
    static constexpr bool PERM = true;
    bf16_t* Gm; const float* bias;
    __device__ __forceinline__ void operator()(const Acc& acc, const pg8::Unit& u, int wr, int wc, int fr, int fq) const {
        asm volatile("" : "+v"(fr), "+v"(fq));
        const int row0 = u.pm * 256 + wr * 64 + fr, col0 = u.pn * 256 + wc * 32 + 8 * fq;
        f32x4 bv[2][2];
#pragma unroll
        for (int bj = 0; bj < 2; ++bj)
#pragma unroll
            for (int n = 0; n < 2; ++n) bv[bj][n] = *(const f32x4*)(bias + col0 + bj * 128 + 4 * n);
#pragma unroll
        for (int ai = 0; ai < 2; ++ai)
#pragma unroll
            for (int m = 0; m < 4; ++m) { bf16_t* rowp = Gm + (size_t)(row0 + ai * 128 + m * 16) * 4096 + col0;
#pragma unroll
                for (int bj = 0; bj < 2; ++bj) { f32x4 v0 = acc[ai][bj][m][0] + bv[bj][0], v1 = acc[ai][bj][m][1] + bv[bj][1];
#pragma unroll
                    for (int j = 0; j < 4; ++j) { v0[j] = sigmoid_f(v0[j]); v1[j] = sigmoid_f(v1[j]); }
                    *(u32x4*)(rowp + bj * 128) = pack8(v0, v1); } }
    }
};
struct EpiMerge {
    static constexpr bool PERM = true;
    const bf16_t* Gm; bf16_t* Mg;
    __device__ __forceinline__ void operator()(const Acc& acc, const pg8::Unit& u, int wr, int wc, int fr, int fq) const {
        asm volatile("" : "+v"(fr), "+v"(fq));
        const int row0 = u.pm * 256 + wr * 64 + fr, col0 = u.pn * 256 + wc * 32 + 8 * fq, b = u.aux;
#pragma unroll
        for (int ai = 0; ai < 2; ++ai)
#pragma unroll
            for (int m = 0; m < 4; ++m) { const unsigned row = (unsigned)(row0 + ai * 128 + m * 16);
#pragma unroll
                for (int bj = 0; bj < 2; ++bj) {
                    f32x4 g0, g1; unpack8(*(const u32x4*)(Gm + (row * 4096u + (unsigned)(b * 1024 + col0 + bj * 128))), g0, g1);
                    f32x4 v0 = acc[ai][bj][m][0] * g0, v1 = acc[ai][bj][m][1] * g1;
                    bf16_t* mp = Mg + (row * 1024u + (unsigned)(col0 + bj * 128));
                    if (b > 0) {
                        const unsigned long long q0 = __hip_atomic_load((const unsigned long long*)mp, __ATOMIC_RELAXED, __HIP_MEMORY_SCOPE_AGENT), q1 = __hip_atomic_load((const unsigned long long*)mp + 1, __ATOMIC_RELAXED, __HIP_MEMORY_SCOPE_AGENT);
                        f32x4 p0, p1; unpack8((u32x4){(unsigned)q0, (unsigned)(q0 >> 32), (unsigned)q1, (unsigned)(q1 >> 32)}, p0, p1); v0 += p0; v1 += p1; }
                    *(u32x4*)mp = pack8(v0, v1); }
                asm volatile("" ::: "memory"); }
    }
};
struct EpiWo {
    static constexpr bool PERM = true;
    const float* xin; float* x1;
    __device__ __forceinline__ void operator()(const Acc& acc, const pg8::Unit& u, int wr, int wc, int fr, int fq) const {
        asm volatile("" : "+v"(fr), "+v"(fq));
        const int row0 = u.pm * 256 + wr * 64 + fr, col0 = u.pn * 256 + wc * 32 + 8 * fq;
#pragma unroll
        for (int ai = 0; ai < 2; ++ai)
#pragma unroll
            for (int m = 0; m < 4; ++m) { const unsigned ro = (unsigned)(row0 + ai * 128 + m * 16) * 1024u + (unsigned)col0;
#pragma unroll
                for (int bj = 0; bj < 2; ++bj)
#pragma unroll
                    for (int n = 0; n < 2; ++n) { const unsigned o = ro + bj * 128 + 4 * n; *(f32x4*)(x1 + o) = *(const f32x4*)(xin + o) + acc[ai][bj][m][n]; }
                asm volatile("" ::: "memory"); }
    }
};
struct EpiMoeUp {
    static constexpr bool PERM = true;
    bf16_t* hid; const float* slot_w;
    __device__ __forceinline__ void operator()(const Acc& acc, const pg8::Unit& u, int wr, int wc, int fr, int fq) const {
        asm volatile("" : "+v"(fr), "+v"(fq));
        const int row0 = u.pm * 256 + wr * 64 + fr, col0 = (u.pn >> 1) * 256 + (u.pn & 1) * 128 + wc * 32 + 8 * fq, k = u.pn >> 1;
#pragma unroll
        for (int ai = 0; ai < 2; ++ai)
#pragma unroll
            for (int m = 0; m < 4; ++m) { const size_t row = (size_t)(row0 + ai * 128 + m * 16); const float w = slot_w[row * 2 + k];
                f32x4 x0, x1; const f32x4 a0 = acc[ai][0][m][0], a1 = acc[ai][0][m][1], b0 = acc[ai][1][m][0], b1 = acc[ai][1][m][1];
#pragma unroll
                for (int j = 0; j < 4; ++j) { x0[j] = silu_f(a0[j]) * b0[j] * w; x1[j] = silu_f(a1[j]) * b1[j] * w; }
                *(u32x4*)(hid + row * 512 + col0) = pack8(x0, x1); }
    }
};
struct EpiMoeDown {
    static constexpr bool PERM = true;
    const int* slot_tok; const float* x1; float* out;
    __device__ __forceinline__ void operator()(const Acc& acc, const pg8::Unit& u, int wr, int wc, int fr, int fq) const {
        asm volatile("" : "+v"(fr), "+v"(fq));
        const int row0 = u.pm * 256 + wr * 64 + fr, col0 = u.pn * 256 + wc * 32 + 8 * fq;
#pragma unroll
        for (int ai = 0; ai < 2; ++ai)
#pragma unroll
            for (int m = 0; m < 4; ++m) { const int tok = slot_tok[row0 + ai * 128 + m * 16];
                if (tok >= 0) { const unsigned ro = (unsigned)tok * 1024u + (unsigned)col0;
#pragma unroll
                    for (int bj = 0; bj < 2; ++bj)
#pragma unroll
                        for (int n = 0; n < 2; ++n) { const unsigned o = ro + bj * 128 + 4 * n; *(f32x4*)(out + o) = *(const f32x4*)(x1 + o) + ((ABL & 16) ? acc[ai][bj][m][n] * 0.f : acc[ai][bj][m][n]); } }
                asm volatile("" ::: "memory"); }
    }
};

enum InIdx { I_X = 0, I_POS, I_N1G, I_WIN, I_SLNG, I_SLNB, I_SGUW, I_SGUB, I_QNG, I_KNG, I_SINK, I_C3W, I_C31W, I_C31B, I_CNG, I_CNB, I_WBR, I_WGATE, I_BGATE, I_WO,
             I_N2G, I_WGRP, I_BGRP, I_WEXP, I_BEXP, I_WEG, I_WEU, I_WED, N_IN };
struct Args { const void* in[N_IN]; float* out; unsigned char* ws; int ph_lo, ph_hi; };
struct Frame {
    LAS unsigned char* lds; unsigned char* ws; unsigned* ctl;
    int tid, lane, wave, vcu, G;
};
#define LDS_WAIT() asm volatile("s_waitcnt lgkmcnt(0)" ::: "memory")

__device__ __forceinline__ void p0_transpose_item(const float* W, int N, bf16_t* WT, int Kd, int k0, int n0, int drow0, LAS float* scr, int lane) {
#pragma unroll 8
    for (int i = 0; i < 32; ++i) { const int kk = 2 * i + (lane >> 5); scr[kk * 33 + (lane & 31)] = W[(size_t)(k0 + kk) * N + n0 + (lane & 31)]; }
    LDS_WAIT(); asm volatile("" ::: "memory");
    const int c = lane & 7;
#pragma unroll
    for (int j = 0; j < 4; ++j) { const int n = (lane >> 3) + 8 * j; const LAS float* s = scr + (8 * c) * 33 + n;
        u32x4 o; o.x = cvt_pk_bf16(s[0 * 33], s[1 * 33]); o.y = cvt_pk_bf16(s[2 * 33], s[3 * 33]); o.z = cvt_pk_bf16(s[4 * 33], s[5 * 33]); o.w = cvt_pk_bf16(s[6 * 33], s[7 * 33]);
        *(u32x4*)(WT + (size_t)(drow0 + n) * Kd + k0 + 8 * c) = o; }
    LDS_WAIT(); asm volatile("" ::: "memory");
}
__device__ __forceinline__ int win_dest_row(int s0) {
    if (s0 < 512) return s0;
    if (s0 < 768)  { const int r = s0 - 512, h = r >> 6, bj = (r >> 5) & 1; return 512 + 128 * bj + 32 * h; }
    if (s0 < 896)  { const int r = s0 - 768, h = r >> 6, bj = (r >> 5) & 1; return 768 + 128 * bj + 32 * h; }
    if (s0 < 1024) { const int r = s0 - 896, h = r >> 6, bj = (r >> 5) & 1; return 768 + 128 * bj + 32 * (h + 2); }
    if (s0 < 1280) { const int ch = s0 - 1024; return (4 + (ch >> 7)) * 256 + (ch & 127); }
    if (s0 < 1536) return 6 * 256 + (s0 - 1280);
    if (s0 < 1792) { const int ch = s0 - 1536; return (4 + (ch >> 7)) * 256 + 128 + (ch & 127); }
    if (s0 < 2048) { const int ch = s0 - 1792; return (7 + (ch >> 7)) * 256 + (ch & 127); }
    { const int ch = s0 - 2048; return (7 + (ch >> 7)) * 256 + 128 + (ch & 127); }
}
constexpr int IT_WIN = 16 * 72, IT_WGATE = 16 * 128, IT_WBR = 4 * 4 * 32, IT_WO = 16 * 32, IT_EG = 16 * 16 * 8, IT_EU = IT_EG, IT_ED = 16 * 4 * 32;
constexpr int IT_LAYER = IT_WIN + IT_WGATE + IT_WBR + IT_WO + IT_EG + IT_EU + IT_ED;
__device__ __forceinline__ void p0_weights(const Frame& F0, const Args& a) {
    Frame F = F0; F.lane = lane_id_now(); F.tid = F.wave * 64 + F.lane; asm volatile("" : "+s"(F.G), "+s"(F.vcu));
    LAS float* scr = (LAS float*)(F.lds + F.wave * 16384);
    const int gw = F.vcu * NWAVES + F.wave, NGW = F.G * NWAVES;
    for (int it = gw; it < DEPTH * IT_LAYER; it += NGW) {
        const int l = it / IT_LAYER; int r = it - l * IT_LAYER;
        unsigned char* wl = F.ws + WS_W + (size_t)l * W_LAYER;
        if (r < IT_WIN) { const int kb = r / 72, nb = r % 72; p0_transpose_item((const float*)a.in[I_WIN] + (size_t)l * D * DIN, DIN, (bf16_t*)(wl + W_IN), D, 64 * kb, 32 * nb, win_dest_row(32 * nb), scr, F.lane); continue; } r -= IT_WIN;
        if (r < IT_WGATE) { const int kb = r / 128, nb = r % 128; p0_transpose_item((const float*)a.in[I_WGATE] + (size_t)l * D * 4096, 4096, (bf16_t*)(wl + W_GATE), D, 64 * kb, 32 * nb, 32 * nb, scr, F.lane); continue; } r -= IT_WGATE;
        if (r < IT_WBR) { const int b = r / 128, q = r % 128, kb = q / 32, nb = q % 32; p0_transpose_item((const float*)a.in[I_WBR] + ((size_t)l * 4 + b) * 256 * D, D, (bf16_t*)(wl + W_BR), 256, 64 * kb, 32 * nb, b * 1024 + 32 * nb, scr, F.lane); continue; } r -= IT_WBR;
        if (r < IT_WO) { const int kb = r / 32, nb = r % 32; p0_transpose_item((const float*)a.in[I_WO] + (size_t)l * D * D, D, (bf16_t*)(wl + W_O), D, 64 * kb, 32 * nb, 32 * nb, scr, F.lane); continue; } r -= IT_WO;
        if (r < IT_EG + IT_EU) { const int up = r >= IT_EG; if (up) r -= IT_EG; const int e = r / 128, q = r % 128, kb = q / 8, nb = q % 8, f0 = 32 * nb;
            const float* src = (const float*)a.in[up ? I_WEU : I_WEG] + ((size_t)l * NEXP + e) * D * DEXP;
            p0_transpose_item(src, DEXP, (bf16_t*)(wl + W_GU), D, 64 * kb, f0, e * 512 + (f0 >> 7) * 256 + up * 128 + (f0 & 127), scr, F.lane); continue; } r -= IT_EG + IT_EU;
        { const int e = r / 128, q = r % 128, kb = q / 32, nb = q % 32;
          p0_transpose_item((const float*)a.in[I_WED] + ((size_t)l * NEXP + e) * DEXP * D, D, (bf16_t*)(wl + W_DN), DEXP, 64 * kb, 32 * nb, e * 1024 + 32 * nb, scr, F.lane); }
    }
    const int gt = F.vcu * NTHREADS + F.tid, NGT = F.G * NTHREADS;
    float* rope = (float*)(F.ws + WS_ROPE); const int* pos = (const int*)a.in[I_POS];
    for (int idx = gt; idx < NTOK * 8; idx += NGT) { const int t = idx >> 3, i = idx & 7;
        const float inv = (float)exp2(-(double)i * (18.931568569324174 / 8.0));
        const float ang = (float)pos[t] * inv; float s, c; sincosf(ang, &s, &c);
        rope[(size_t)t * 16 + i] = c; rope[(size_t)t * 16 + 8 + i] = s; }
    bf16_t* sg = (bf16_t*)(F.ws + WS_SGU); const float* sw = (const float*)a.in[I_SGUW];
    for (int idx = gt; idx < DEPTH * 4 * 128 * 128 / 2; idx += NGT) { const int e = idx * 2, s = e & 127, t = (e >> 7) & 127;
        const float v0 = (s <= t) ? sw[e] : 0.f, v1 = (s + 1 <= t) ? sw[e + 1] : 0.f; ((unsigned*)sg)[idx] = cvt_pk_bf16(v0, v1); }
}
__device__ __forceinline__ void norm_rows(const Frame& F0, const float* x, const float* g, bf16_t* h) {
    Frame F = F0; F.lane = lane_id_now(); F.tid = F.wave * 64 + F.lane; asm volatile("" : "+s"(F.G), "+s"(F.vcu));
    const int gw = F.vcu * NWAVES + F.wave, NGW = F.G * NWAVES;
    f32x4 gv[4];
#pragma unroll
    for (int j = 0; j < 4; ++j) gv[j] = *((const f32x4*)g + F.lane + 64 * j);
    for (int m = gw; m < NTOK; m += NGW) {
        const f32x4* xr = (const f32x4*)(x + (size_t)m * D) + F.lane;
        f32x4 v[4]; float s = 0.f;
#pragma unroll
        for (int j = 0; j < 4; ++j) { v[j] = xr[64 * j]; s += (v[j][0] * v[j][0] + v[j][1] * v[j][1]) + (v[j][2] * v[j][2] + v[j][3] * v[j][3]); }
        const float rs = 1.0f / sqrtf(wave_sum(s) * (1.0f / D) + EPS);
        u32x2* o8 = (u32x2*)(h + (size_t)m * D) + F.lane;
#pragma unroll
        for (int j = 0; j < 4; ++j) { const f32x4 y = v[j] * rs * gv[j]; u32x2 o; o.x = cvt_pk_bf16(y[0], y[1]); o.y = cvt_pk_bf16(y[2], y[3]); o8[64 * j] = o; }
    }
}

struct MixArgs { const bf16_t* P; bf16_t* ys; const bf16_t* sgw; const float *sln_g, *sln_b, *sgu_w, *sgu_b, *sinks, *c3w, *c31w, *c31b, *cn_g, *cn_b; };

typedef float f32x16 __attribute__((ext_vector_type(16)));
__device__ __forceinline__ float max_xor32_f(float v) { const auto r = __builtin_amdgcn_permlane32_swap(__float_as_uint(v), __float_as_uint(v), false, false); return fmaxf(__uint_as_float(r[0]), __uint_as_float(r[1])); }
__device__ __forceinline__ void mix_sgu(const Frame& F0, const MixArgs& A, int t0) {
    Frame F = F0; F.lane = lane_id_now(); F.tid = F.wave * 64 + F.lane;
    LAS bf16_t* vT = (LAS bf16_t*)F.lds;
    const int w = F.wave, lane = F.lane;
    {
        const int tp = lane & 7, cg = lane >> 3;
        const bf16_t* r0 = A.P + (size_t)(t0 + 16 * w + 2 * tp) * PS + P_GV + 32 * cg;
        float x0[32], x1[32];
#pragma unroll
        for (int c = 0; c < 4; ++c) { const u32x4 a = *((const u32x4*)r0 + c), b = *((const u32x4*)(r0 + PS) + c);
            x0[8 * c + 0] = bf_lo(a.x); x0[8 * c + 1] = bf_hi(a.x); x0[8 * c + 2] = bf_lo(a.y); x0[8 * c + 3] = bf_hi(a.y); x0[8 * c + 4] = bf_lo(a.z); x0[8 * c + 5] = bf_hi(a.z); x0[8 * c + 6] = bf_lo(a.w); x0[8 * c + 7] = bf_hi(a.w);
            x1[8 * c + 0] = bf_lo(b.x); x1[8 * c + 1] = bf_hi(b.x); x1[8 * c + 2] = bf_lo(b.y); x1[8 * c + 3] = bf_hi(b.y); x1[8 * c + 4] = bf_lo(b.z); x1[8 * c + 5] = bf_hi(b.z); x1[8 * c + 6] = bf_lo(b.w); x1[8 * c + 7] = bf_hi(b.w); }
        float s0 = 0.f, s1 = 0.f;
#pragma unroll
        for (int k = 0; k < 32; ++k) { s0 += x0[k]; s1 += x1[k]; }
        s0 += dpp_f<0x128>(s0); s0 += xor16_f(s0); s0 = sum_xor32_f(s0);
        s1 += dpp_f<0x128>(s1); s1 += xor16_f(s1); s1 = sum_xor32_f(s1);
        const float m0 = s0 * (1.0f / 256.0f), m1 = s1 * (1.0f / 256.0f);
        float q0 = 0.f, q1 = 0.f;
#pragma unroll
        for (int k = 0; k < 32; ++k) { x0[k] -= m0; x1[k] -= m1; q0 += x0[k] * x0[k]; q1 += x1[k] * x1[k]; }
        q0 += dpp_f<0x128>(q0); q0 += xor16_f(q0); q0 = sum_xor32_f(q0);
        q1 += dpp_f<0x128>(q1); q1 += xor16_f(q1); q1 = sum_xor32_f(q1);
        const float rs0 = 1.0f / sqrtf(q0 * (1.0f / 256.0f) + EPS), rs1 = 1.0f / sqrtf(q1 * (1.0f / 256.0f) + EPS);
        LAS unsigned* wp = (LAS unsigned*)(vT + (32 * cg) * 136 + 16 * w + 2 * tp);
#pragma unroll
        for (int c = 0; c < 8; ++c) { const f32x4 g = *(const f32x4*)(A.sln_g + 32 * cg + 4 * c), bb = *(const f32x4*)(A.sln_b + 32 * cg + 4 * c);
#pragma unroll
            for (int j = 0; j < 4; ++j) { const int k = 4 * c + j; wp[k * 68] = cvt_pk_bf16(x0[k] * rs0 * g[j] + bb[j], x1[k] * rs1 * g[j] + bb[j]); } }
    }
    __syncthreads();
    const int fr = lane & 15, fq = lane >> 4, t = 16 * w + fr, nks = (w >> 1) + 1;
#pragma unroll 1
    for (int g = 0; g < 4; ++g) {
        f32x4 acc[4];
#pragma unroll
        for (int ct = 0; ct < 4; ++ct) acc[ct] = (f32x4){0.f, 0.f, 0.f, 0.f};
        const bf16_t* wrow = A.sgw + (size_t)(g * 128 + t) * 128 + 8 * fq;
        const LAS bf16_t* vrow = vT + (g * 64 + fr) * 136 + 8 * fq;
#pragma unroll
        for (int ks = 0; ks < 4; ++ks) if (ks < nks) {
            const bf16x8 bw = *(const bf16x8*)(wrow + 32 * ks);
#pragma unroll
            for (int ct = 0; ct < 4; ++ct) { const bf16x8 av = *(const LAS bf16x8*)(vrow + ct * 16 * 136 + 32 * ks); acc[ct] = __builtin_amdgcn_mfma_f32_16x16x32_bf16(av, bw, acc[ct], 0, 0, 0); } }
        const float bias = A.sgu_b[g * 128 + t];
#pragma unroll
        for (int ct = 0; ct < 4; ++ct) { const int c = g * 64 + 16 * ct + 4 * fq;
            const u32x2 uw = *(const u32x2*)(A.P + (size_t)(t0 + t) * PS + P_U + c);
            u32x2 o; o.x = cvt_pk_bf16(bf_lo(uw.x) * (acc[ct][0] + bias), bf_hi(uw.x) * (acc[ct][1] + bias)); o.y = cvt_pk_bf16(bf_lo(uw.y) * (acc[ct][2] + bias), bf_hi(uw.y) * (acc[ct][3] + bias));
            *(u32x2*)(A.ys + (size_t)(t0 + t) * 1024 + c) = o; }
    }
    __syncthreads();
}
__device__ __forceinline__ void mix_attn(const Frame& F0, const MixArgs& A, int t0, bool first) {
    Frame F = F0; F.lane = lane_id_now(); F.tid = F.wave * 64 + F.lane;
    LAS bf16_t* Ks = (LAS bf16_t*)F.lds;
    LAS bf16_t* Vt = (LAS bf16_t*)(F.lds + 36864);
    const int w = F.wave, lane = F.lane, l31 = lane & 31, h = lane >> 5;
#pragma unroll 1
    for (int hk = 0; hk < 2; ++hk) {
        __syncthreads();
        for (int idx = F.tid; idx < 2048; idx += NTHREADS) { const int j = idx >> 3, ch = idx & 7;
            u32x4 v = (u32x4){0u, 0u, 0u, 0u};
            if (!(first && j < 128)) v = *(const u32x4*)(A.P + (size_t)(t0 - 128 + j) * PS + P_K + hk * 64 + ch * 8);
            *(LAS u32x4*)(Ks + j * 72 + ch * 8) = v; }
        for (int it = F.tid; it < 1024; it += NTHREADS) { const int kp = it & 127, dg = it >> 7;
            u32x4 v0 = (u32x4){0u, 0u, 0u, 0u}, v1 = v0;
            if (!(first && kp < 64)) { const bf16_t* src = A.P + (size_t)(t0 - 128 + 2 * kp) * PS + P_V + hk * 64 + dg * 8; v0 = *(const u32x4*)src; v1 = *(const u32x4*)(src + PS); }
            LAS unsigned* dst = (LAS unsigned*)(Vt + (8 * dg) * 260 + 2 * kp);
            dst[0 * 130] = (v0.x & 0xffffu) | (v1.x << 16); dst[1 * 130] = (v0.x >> 16) | (v1.x & 0xffff0000u);
            dst[2 * 130] = (v0.y & 0xffffu) | (v1.y << 16); dst[3 * 130] = (v0.y >> 16) | (v1.y & 0xffff0000u);
            dst[4 * 130] = (v0.z & 0xffffu) | (v1.z << 16); dst[5 * 130] = (v0.z >> 16) | (v1.z & 0xffff0000u);
            dst[6 * 130] = (v0.w & 0xffffu) | (v1.w << 16); dst[7 * 130] = (v0.w >> 16) | (v1.w & 0xffff0000u); }
        __syncthreads();
        const int head = 2 * hk + (w >> 2), qb = w & 3, qi = 32 * qb + l31;
        bf16x8 bq[4];
        { const bf16_t* qp = A.P + (size_t)(t0 + qi) * PS + P_Q + head * 64 + 8 * h;
#pragma unroll
          for (int ks = 0; ks < 4; ++ks) bq[ks] = *(const bf16x8*)(qp + 16 * ks); }
        f32x16 sc[5];
#pragma unroll
        for (int it = 0; it < 5; ++it) {
#pragma unroll
            for (int r = 0; r < 16; ++r) sc[it][r] = 0.f;
            const LAS bf16_t* kp = Ks + (32 * (qb + it) + l31) * 72 + 8 * h;
#pragma unroll
            for (int ks = 0; ks < 4; ++ks) sc[it] = __builtin_amdgcn_mfma_f32_32x32x16_bf16(*(const LAS bf16x8*)(kp + 16 * ks), bq[ks], sc[it], 0, 0, 0); }
        const float sink = A.sinks[head];
        float mx = sink;
        int qiv = qi; asm volatile("" : "+v"(qiv));
#pragma unroll
        for (int it = 0; it < 5; ++it) {
            const bool dead = first && (qb + it) < 4;
#pragma unroll
            for (int r = 0; r < 16; ++r) { const int kb = 32 * (qb + it) + (r & 3) + 8 * (r >> 2) + 4 * h;
                bool valid = !dead;
                if (it == 0) valid = valid && (kb > qiv);
                if (it == 4) valid = valid && (kb <= qiv + 128);
                const float v = valid ? sc[it][r] : -INFINITY; sc[it][r] = v; mx = fmaxf(mx, v); } }
        mx = max_xor32_f(mx);
        float l = 0.f;
#pragma unroll
        for (int it = 0; it < 5; ++it)
#pragma unroll
            for (int r = 0; r < 16; ++r) { const float p = __builtin_amdgcn_exp2f((sc[it][r] - mx) * 1.44269504089f); sc[it][r] = p; l += p; }
        l = sum_xor32_f(l) + __builtin_amdgcn_exp2f((sink - mx) * 1.44269504089f);
        f32x16 o[2];
#pragma unroll
        for (int dt = 0; dt < 2; ++dt)
#pragma unroll
            for (int r = 0; r < 16; ++r) o[dt][r] = 0.f;
#pragma unroll
        for (int it = 0; it < 5; ++it)
#pragma unroll
            for (int st = 0; st < 2; ++st) {
                union { u32x4 u; bf16x8 v; } pb;
                pb.u.x = cvt_pk_bf16(sc[it][8 * st + 0], sc[it][8 * st + 1]); pb.u.y = cvt_pk_bf16(sc[it][8 * st + 2], sc[it][8 * st + 3]);
                pb.u.z = cvt_pk_bf16(sc[it][8 * st + 4], sc[it][8 * st + 5]); pb.u.w = cvt_pk_bf16(sc[it][8 * st + 6], sc[it][8 * st + 7]);
#pragma unroll
                for (int dt = 0; dt < 2; ++dt) { const LAS bf16_t* vp = Vt + (32 * dt + l31) * 260 + 32 * (qb + it) + 16 * st + 4 * h;
                    union { u32x4 u; bf16x8 v; } va; const u32x2 lo = *(const LAS u32x2*)vp, hi = *(const LAS u32x2*)(vp + 8);
                    va.u = (u32x4){lo.x, lo.y, hi.x, hi.y};
                    o[dt] = __builtin_amdgcn_mfma_f32_32x32x16_bf16(va.v, pb.v, o[dt], 0, 0, 0); } }
        const float il = 1.0f / l;
        bf16_t* op = A.ys + (size_t)(t0 + qi) * 1024 + 256 + head * 64 + 4 * h;
#pragma unroll
        for (int dt = 0; dt < 2; ++dt)
#pragma unroll
            for (int g4 = 0; g4 < 4; ++g4) { u32x2 ov; ov.x = cvt_pk_bf16(o[dt][4 * g4] * il, o[dt][4 * g4 + 1] * il); ov.y = cvt_pk_bf16(o[dt][4 * g4 + 2] * il, o[dt][4 * g4 + 3] * il);
                *(u32x2*)(op + 32 * dt + 8 * g4) = ov; }
    }
    __syncthreads();
}
__device__ __forceinline__ void mix_conv3(const Frame& F0, const MixArgs& A, int t0, bool first) {
    Frame F = F0; F.lane = lane_id_now(); F.tid = F.wave * 64 + F.lane;
    const int c8 = (F.tid & 31) * 8, tq = (F.tid >> 5) * 8;
    f32x4 w[3][2];
#pragma unroll
    for (int j = 0; j < 3; ++j) { w[j][0] = *(const f32x4*)(A.c3w + j * 256 + c8); w[j][1] = *(const f32x4*)(A.c3w + j * 256 + c8 + 4); }
    f32x4 x[10][2];
#pragma unroll
    for (int r = 0; r < 10; ++r) { const int t = tq - 2 + r;
        if (t < 0 && first) { x[r][0] = (f32x4){0.f, 0.f, 0.f, 0.f}; x[r][1] = x[r][0]; }
        else unpack8(*(const u32x4*)(A.P + (size_t)(t0 + t) * PS + P_BX + c8), x[r][0], x[r][1]); }
#pragma unroll
    for (int i = 0; i < 8; ++i) { f32x4 cc0, cc1; unpack8(*(const u32x4*)(A.P + (size_t)(t0 + tq + i) * PS + P_CC + c8), cc0, cc1);
        const f32x4 y0 = w[0][0] * x[i][0] + w[1][0] * x[i + 1][0] + w[2][0] * x[i + 2][0], y1 = w[0][1] * x[i][1] + w[1][1] * x[i + 1][1] + w[2][1] * x[i + 2][1];
        *(u32x4*)(A.ys + (size_t)(t0 + tq + i) * 1024 + 512 + c8) = pack8(cc0 * y0, cc1 * y1); }
}
__device__ __forceinline__ void mix_conv31(const Frame& F0, const MixArgs& A, int t0, bool first) {
    Frame F = F0; F.lane = lane_id_now(); F.tid = F.wave * 64 + F.lane;
    LAS bf16_t* gl = (LAS bf16_t*)F.lds;
    for (int idx = F.tid; idx < 158 * 32; idx += NTHREADS) { const int r = idx >> 5, ch = idx & 31;
        u32x4 w = (u32x4){0u, 0u, 0u, 0u};
        if (!(first && r < 30)) w = *(const u32x4*)(A.P + (size_t)(t0 - 30 + r) * PS + P_GLU + ch * 8);
        *(LAS u32x4*)(gl + r * 256 + ch * 8) = w; }
    __syncthreads();
    const int c4 = F.lane * 4, tr = F.wave * 16;
    const f32x4 bias = *(const f32x4*)(A.c31b + c4);
    f32x4 acc[16];
#pragma unroll
    for (int i = 0; i < 16; ++i) acc[i] = bias;
#pragma unroll 1
    for (int j = 0; j < 31; ++j) { const f32x4 w = *(const f32x4*)(A.c31w + j * 256 + c4);
        const LAS bf16_t* xp = gl + (tr + j) * 256 + c4;
#pragma unroll
        for (int i = 0; i < 16; ++i) { const u32x2 p = *(const LAS u32x2*)(xp + i * 256); acc[i] += w * (f32x4){bf_lo(p.x), bf_hi(p.x), bf_lo(p.y), bf_hi(p.y)}; } }
    const f32x4 g = *(const f32x4*)(A.cn_g + c4), b = *(const f32x4*)(A.cn_b + c4);
#pragma unroll
    for (int i = 0; i < 16; ++i) {
        f32x4 v = acc[i];
        const float mean = wave_sum((v[0] + v[1]) + (v[2] + v[3])) * (1.0f / 256.0f);
        v = v - mean;
        const float var = wave_sum((v[0] * v[0] + v[1] * v[1]) + (v[2] * v[2] + v[3] * v[3])) * (1.0f / 256.0f);
        const float rstd = 1.0f / sqrtf(var + EPS);
        v = v * rstd * g + b;
        u32x2 o; o.x = cvt_pk_bf16(silu_f(v[0]), silu_f(v[1])); o.y = cvt_pk_bf16(silu_f(v[2]), silu_f(v[3]));
        *(u32x2*)(A.ys + (size_t)(t0 + tr + i) * 1024 + 768 + c4) = o; }
    __syncthreads();
}
__device__ __forceinline__ void mixer_phase(const Frame& F0, const MixArgs& A) {
    Frame F = F0; F.lane = lane_id_now(); F.tid = F.wave * 64 + F.lane; asm volatile("" : "+s"(F.G), "+s"(F.vcu));
    for (int ch = F.vcu; ch < NTOK / 128; ch += F.G) {
        const int t0 = ch * 128; const bool first = (ch % (SEQ / 128)) == 0;
        #ifndef MIX_MASK
#define MIX_MASK 15
#endif
        if (MIX_MASK & 1) mix_sgu(F, A, t0); if (MIX_MASK & 2) mix_attn(F, A, t0, first); if (MIX_MASK & 4) mix_conv3(F, A, t0, first); if (MIX_MASK & 8) mix_conv31(F, A, t0, first);
        if (ABL & 15) { __syncthreads(); for (int idx = F.tid; idx < 128 * 128; idx += NTHREADS) { const int r = idx >> 7, c8 = (idx & 127) * 8, br = c8 >> 8;
            if ((ABL >> br) & 1) *(u32x4*)(A.ys + (size_t)(t0 + r) * 1024 + c8) = (u32x4){0u, 0u, 0u, 0u}; } }
    }
}

struct RouteArgs { const float* x1; const float* g2; const float *wgrp, *bgrp, *wexp, *bexp; float* rs; int* bkt; float *wlo, *whi; int* slot_tok; unsigned* counts; };
__device__ __forceinline__ void router_phase(const Frame& F0, const RouteArgs& R) {
    Frame F = F0; F.lane = lane_id_now(); F.tid = F.wave * 64 + F.lane; asm volatile("" : "+s"(F.G), "+s"(F.vcu));
    LAS float* Wr = (LAS float*)F.lds;
    LAS unsigned* hist = (LAS unsigned*)(F.lds + 20 * 1024 * 4);
    for (int idx = F.tid; idx < 1024 * 4; idx += NTHREADS) Wr[(idx & 3) * 1024 + (idx >> 2)] = R.wgrp[idx];
    for (int idx = F.tid; idx < 1024 * 16; idx += NTHREADS) Wr[(4 + (idx & 15)) * 1024 + (idx >> 4)] = R.wexp[idx];
    if (F.tid < 32) hist[F.tid] = 0u;
    { const int gt = F.vcu * NTHREADS + F.tid, NGT = F.G * NTHREADS; for (int idx = gt; idx < MPAD_MAX; idx += NGT) R.slot_tok[idx] = -1; }
    __syncthreads();
    f32x4 gv[4];
#pragma unroll
    for (int j = 0; j < 4; ++j) gv[j] = *((const f32x4*)R.g2 + F.lane + 64 * j);
    const int gw = F.vcu * NWAVES + F.wave, NGW = F.G * NWAVES;
    for (int grp = gw; grp < NTOK / 16; grp += NGW)
        for (int i = 0; i < 16; ++i) {
            const int tok = grp * 16 + i;
            const f32x4* xr = (const f32x4*)(R.x1 + (size_t)tok * D) + F.lane;
            f32x4 v[4]; float s = 0.f;
#pragma unroll
            for (int j = 0; j < 4; ++j) { v[j] = xr[64 * j]; s += (v[j][0] * v[j][0] + v[j][1] * v[j][1]) + (v[j][2] * v[j][2] + v[j][3] * v[j][3]); }
            const float rs = 1.0f / sqrtf(wave_sum(s) * (1.0f / D) + EPS);
#pragma unroll
            for (int j = 0; j < 4; ++j) v[j] = v[j] * rs * gv[j];
            float lg[20];
#pragma unroll
            for (int c = 0; c < 20; ++c) { float a = 0.f;
#pragma unroll
                for (int j = 0; j < 4; ++j) { const f32x4 w = *((const LAS f32x4*)(Wr + c * 1024) + F.lane + 64 * j); a += (v[j][0] * w[0] + v[j][1] * w[1]) + (v[j][2] * w[2] + v[j][3] * w[3]); }
                lg[c] = wave_sum(a); }
            float gl[4]; int gi = 0;
#pragma unroll
            for (int k = 0; k < 4; ++k) gl[k] = lg[k] + R.bgrp[k];
            float gm = gl[0];
#pragma unroll
            for (int k = 1; k < 4; ++k) if (gl[k] > gm) { gm = gl[k]; gi = k; }
            float den = 0.f;
#pragma unroll
            for (int k = 0; k < 4; ++k) den += expf(gl[k] - gm);
            const float gwt = 1.0f / den;
            float el[4];
#pragma unroll
            for (int k = 0; k < 4; ++k) { const float a0 = lg[4 + k], a1 = lg[8 + k], a2 = lg[12 + k], a3 = lg[16 + k];
                el[k] = (gi == 0 ? a0 : gi == 1 ? a1 : gi == 2 ? a2 : a3) + R.bexp[gi * 4 + k]; }
            int i1 = 0; float v1 = el[0];
#pragma unroll
            for (int k = 1; k < 4; ++k) if (el[k] > v1) { v1 = el[k]; i1 = k; }
            int i2 = -1; float v2 = 0.f;
#pragma unroll
            for (int k = 0; k < 4; ++k) if (k != i1 && (i2 < 0 || el[k] > v2)) { v2 = el[k]; i2 = k; }
            const float e2 = expf(v2 - v1), tw1 = gwt / (1.0f + e2), tw2 = gwt * e2 / (1.0f + e2);
            const int lo = i1 < i2 ? i1 : i2, hi = i1 < i2 ? i2 : i1;
            const int pr = lo == 0 ? hi - 1 : (lo == 1 ? hi + 1 : 5);
            const int bucket = gi * 6 + pr;
            if (F.lane == 0) { R.rs[tok] = rs; R.bkt[tok] = bucket; R.wlo[tok] = i1 < i2 ? tw1 : tw2; R.whi[tok] = i1 < i2 ? tw2 : tw1; __hip_atomic_fetch_add(&hist[bucket], 1u, __ATOMIC_RELAXED, __HIP_MEMORY_SCOPE_WORKGROUP); }
        }
    __syncthreads();
    if (F.tid < NBUCKET && hist[F.tid]) xb_add(R.counts + F.tid, hist[F.tid]);
    __syncthreads();
}
struct SlotArgs { const float* x1; const float* g2; const float* rs; const int* bkt; const float *wlo, *whi; int* slot_tok; float* slot_w; bf16_t* h2s; unsigned* counts; unsigned* cursor; unsigned* ntiles; unsigned* tile_bucket; };
__device__ __forceinline__ void slot_phase(const Frame& F0, const SlotArgs& S) {
    Frame F = F0; F.lane = lane_id_now(); F.tid = F.wave * 64 + F.lane; asm volatile("" : "+s"(F.G), "+s"(F.vcu));
    LAS int* offs = (LAS int*)F.lds;
    LAS unsigned* lcnt = (LAS unsigned*)(F.lds + 128);
    LAS unsigned* base = (LAS unsigned*)(F.lds + 256);
    if (F.tid == 0) { int off = 0; for (int b = 0; b < NBUCKET; ++b) { const int c = (int)xb_ld(S.counts + b); offs[b] = off; off += (c + 255) & ~255; } offs[NBUCKET] = off; }
    __syncthreads();
    const int nT = offs[NBUCKET] >> 8;
    if (blockIdx.x == 0) {
        if (F.tid == 0) __hip_atomic_store(S.ntiles, (unsigned)nT, __ATOMIC_RELAXED, __HIP_MEMORY_SCOPE_AGENT);
        if (F.tid < nT) { int tb = 0; for (int b = 0; b < NBUCKET; ++b) if (F.tid * 256 >= offs[b] && F.tid * 256 < offs[b + 1]) tb = b;
            __hip_atomic_store(S.tile_bucket + F.tid, (unsigned)tb, __ATOMIC_RELAXED, __HIP_MEMORY_SCOPE_AGENT); }
    }
    f32x4 gv[4];
#pragma unroll
    for (int j = 0; j < 4; ++j) gv[j] = *((const f32x4*)S.g2 + F.lane + 64 * j);
    for (int tb = F.vcu; tb < NTOK / 128; tb += F.G) {
        if (F.tid < NBUCKET) lcnt[F.tid] = 0u;
        __syncthreads();
        const int tokl = tb * 128 + F.wave * 16 + (F.lane & 15);
        int bk = 0; unsigned rank = 0; float rsv = 0.f;
        if (F.lane < 16) { bk = S.bkt[tokl]; rsv = S.rs[tokl]; rank = __hip_atomic_fetch_add(&lcnt[bk], 1u, __ATOMIC_RELAXED, __HIP_MEMORY_SCOPE_WORKGROUP); }
        __syncthreads();
        if (F.tid < NBUCKET) base[F.tid] = lcnt[F.tid] ? xb_add(S.cursor + F.tid, lcnt[F.tid]) : 0u;
        __syncthreads();
        int slot = 0;
        if (F.lane < 16) { slot = offs[bk] + (int)base[bk] + (int)rank; S.slot_tok[slot] = tokl; S.slot_w[slot * 2] = S.wlo[tokl]; S.slot_w[slot * 2 + 1] = S.whi[tokl]; }
#pragma unroll
        for (int i = 0; i < 16; ++i) {
            const int si = __builtin_amdgcn_readlane(slot, i); const float rs = __int_as_float(__builtin_amdgcn_readlane(__float_as_int(rsv), i));
            const f32x4* xr = (const f32x4*)(S.x1 + (size_t)(tb * 128 + F.wave * 16 + i) * D) + F.lane;
            u32x2* o8 = (u32x2*)(S.h2s + (size_t)si * D) + F.lane;
#pragma unroll
            for (int j = 0; j < 4; ++j) { const f32x4 y = xr[64 * j] * rs * gv[j]; u32x2 o; o.x = cvt_pk_bf16(y[0], y[1]); o.y = cvt_pk_bf16(y[2], y[3]); o8[64 * j] = o; }
        }
        __syncthreads();
    }
}

constexpr int N_PHASES = 1 + 10 * DEPTH;
#ifndef PH_MASK
#define PH_MASK 0x7ff
#endif
#define PHON(k) (((PH_MASK) >> (k)) & 1)
__global__ void __launch_bounds__(NTHREADS, 2) fwd(Args args) {
    extern __shared__ __attribute__((aligned(16))) unsigned char lds[];
    Frame F;
    F.lds = (LAS unsigned char*)lds; F.ws = args.ws; F.ctl = (unsigned*)(args.ws + WS_CTL);
    F.wave = __builtin_amdgcn_readfirstlane((int)threadIdx.x >> 6); F.lane = 0; F.tid = 0;
    F.G = gridDim.x; { const int bx = blockIdx.x; F.vcu = (F.G % 8 == 0) ? (bx % 8) * (F.G / 8) + bx / 8 : bx; }
    volatile LAS unsigned* lctl = (volatile LAS unsigned*)(F.lds + LDSCTL_OFF);
    if (threadIdx.x < 64) lctl[threadIdx.x] = 0u;
    __syncthreads();
    const int lo = args.ph_lo, hi = args.ph_hi;
    XcdBarrier bar; bar.bar = F.ctl + CW_BAR; bar.x = 0; bar.st = lctl; bar.wave = F.wave;
    if (hi - lo > 1) bar = xcd_barrier_post(F.ctl + CW_BAR, lctl);
#define IN(k) (lo <= (k) && (k) < hi)
#define SEAM(k) do { if (IN(k) && IN((k) + 1)) xcd_barrier(bar); } while (0)
    unsigned char* ws = args.ws;
    const float* x0 = (const float*)args.in[I_X];
    bf16_t* Hb = (bf16_t*)(ws + WS_HM); bf16_t* Pb = (bf16_t*)(ws + WS_BIG); bf16_t* Gb = (bf16_t*)(ws + WS_BIG); bf16_t* Mg = (bf16_t*)(ws + WS_HM);
    bf16_t* Ys = (bf16_t*)(ws + WS_YS); float* X1 = (float*)(ws + BIG_X1); bf16_t* H2s = (bf16_t*)(ws + BIG_H2S); bf16_t* Hid = (bf16_t*)(ws + BIG_HID);
    float* aux_rs = (float*)(ws + AUX_RS); int* aux_bkt = (int*)(ws + AUX_BKT); float* aux_wlo = (float*)(ws + AUX_WLO); float* aux_whi = (float*)(ws + AUX_WHI);
    int* slot_tok = (int*)(ws + AUX_STOK); float* slot_w = (float*)(ws + AUX_SW); unsigned* tile_bucket = (unsigned*)(ws + AUX_TB);

    if (PHON(0) && IN(0)) { p0_weights(F, args); norm_rows(F, x0, (const float*)args.in[I_N1G], Hb); }
    SEAM(0);
    for (int l = 0; l < DEPTH; ++l) {
        const int pb = 1 + 10 * l;
        const float* xin = (l == 0) ? x0 : (const float*)args.out;
        unsigned char* wl = ws + WS_W + (size_t)l * W_LAYER;
        unsigned* counts = F.ctl + CW_CNT + 64 * l; unsigned* cursor = counts + 32; unsigned* ntiles = counts + 60;
        if (PHON(1) && IN(pb + 0) && l > 0) norm_rows(F, xin, (const float*)args.in[I_N1G] + (size_t)l * D, Hb);
        if (l > 0) SEAM(pb + 0);
        if (PHON(2) && IN(pb + 1)) {
            PlainOrder S{(const char*)Hb, (const char*)(wl + W_IN), 128, 9, F.G, (int)blockIdx.x, (size_t)256 * D * 2, (size_t)256 * D * 2};
            EpiInProj E{Pb, (const float*)(ws + WS_ROPE), (const float*)args.in[I_QNG] + l * 64, (const float*)args.in[I_KNG] + l * 64};
            pg8::gemm_phase<EpiInProj, PlainOrder>(F.lds, F.wave, D, D, D, S, E);
        }
        SEAM(pb + 1);
        if (PHON(3) && IN(pb + 2)) {
            MixArgs A{Pb, Ys, (const bf16_t*)(ws + WS_SGU) + (size_t)l * 4 * 128 * 128, (const float*)args.in[I_SLNG] + l * 256, (const float*)args.in[I_SLNB] + l * 256, (const float*)args.in[I_SGUW] + (size_t)l * 4 * 128 * 128, (const float*)args.in[I_SGUB] + l * 4 * 128,
                      (const float*)args.in[I_SINK] + l * 4, (const float*)args.in[I_C3W] + l * 3 * 256, (const float*)args.in[I_C31W] + l * 31 * 256, (const float*)args.in[I_C31B] + l * 256,
                      (const float*)args.in[I_CNG] + l * 256, (const float*)args.in[I_CNB] + l * 256};
            mixer_phase(F, A);
        }
        SEAM(pb + 2);
        if (PHON(4) && IN(pb + 3)) {
            PlainOrder S{(const char*)Hb, (const char*)(wl + W_GATE), 128, 16, F.G, (int)blockIdx.x, (size_t)256 * D * 2, (size_t)256 * D * 2};
            EpiGate E{Gb, (const float*)args.in[I_BGATE] + (size_t)l * 4096};
            pg8::gemm_phase<EpiGate, PlainOrder>(F.lds, F.wave, D, D, D, S, E);
        }
        SEAM(pb + 3);
        if (PHON(5) && IN(pb + 4)) {
            BranchOrder S{(const char*)Ys, (const char*)(wl + W_BR), F.G, (int)blockIdx.x};
            EpiMerge E{Gb, Mg};
            pg8::gemm_phase<EpiMerge, BranchOrder>(F.lds, F.wave, 256, D, 256, S, E);
        }
        SEAM(pb + 4);
        if (PHON(6) && IN(pb + 5)) {
            PlainOrder S{(const char*)Mg, (const char*)(wl + W_O), 128, 4, F.G, (int)blockIdx.x, (size_t)256 * D * 2, (size_t)256 * D * 2};
            EpiWo E{xin, X1};
            pg8::gemm_phase<EpiWo, PlainOrder>(F.lds, F.wave, D, D, D, S, E);
        }
        SEAM(pb + 5);
        if (PHON(7) && IN(pb + 6)) {
            RouteArgs R{X1, (const float*)args.in[I_N2G] + (size_t)l * D, (const float*)args.in[I_WGRP] + (size_t)l * D * 4, (const float*)args.in[I_BGRP] + l * 4,
                        (const float*)args.in[I_WEXP] + (size_t)l * D * 16, (const float*)args.in[I_BEXP] + l * 16, aux_rs, aux_bkt, aux_wlo, aux_whi, slot_tok, counts};
            router_phase(F, R);
        }
        SEAM(pb + 6);
        if (PHON(8) && IN(pb + 7)) {
            SlotArgs S{X1, (const float*)args.in[I_N2G] + (size_t)l * D, aux_rs, aux_bkt, aux_wlo, aux_whi, slot_tok, slot_w, H2s, counts, cursor, ntiles, tile_bucket};
            slot_phase(F, S);
        }
        SEAM(pb + 7);
        if (PHON(9) && IN(pb + 8)) {
            const int nT = __builtin_amdgcn_readfirstlane((int)xb_ld(ntiles));
            MoeUpOrder S{(const char*)H2s, (const char*)(wl + W_GU), tile_bucket, nT, F.G, F.vcu};
            EpiMoeUp E{Hid, slot_w};
            pg8::gemm_phase<EpiMoeUp, MoeUpOrder>(F.lds, F.wave, D, D, D, S, E);
        }
        SEAM(pb + 8);
        if (PHON(10) && IN(pb + 9)) {
            const int nT = __builtin_amdgcn_readfirstlane((int)xb_ld(ntiles));
            MoeDownOrder S{(const char*)Hid, (const char*)(wl + W_DN), tile_bucket, nT, F.G, F.vcu};
            EpiMoeDown E{slot_tok, X1, args.out};
            pg8::gemm_phase<EpiMoeDown, MoeDownOrder>(F.lds, F.wave, 512, 512, 256, S, E);
        }
        if (l + 1 < DEPTH) SEAM(pb + 9);
    }
#undef IN
#undef SEAM
}

extern "C" void kernel_launch(void* const* d_in, const int* in_sizes, int n_in, void* d_out, int out_size, void* d_ws, size_t ws_size, hipStream_t stream) {
    static int grid = 0;
    if (grid == 0) {
        if (n_in != N_IN || out_size != NTOK * D || ws_size < WS_END) { fprintf(stderr, "kernel_launch: unexpected shapes (n_in %d, out %d, ws %zu); nothing launched\n", n_in, out_size, ws_size); grid = -1; return; }
        int dev = 0, cus = 0, per_cu = 0;
        if (hipGetDevice(&dev) != hipSuccess || hipDeviceGetAttribute(&cus, hipDeviceAttributeMultiprocessorCount, dev) != hipSuccess) { grid = -1; return; }
        if (hipFuncSetAttribute((const void*)fwd, hipFuncAttributeMaxDynamicSharedMemorySize, LDS_BYTES) != hipSuccess) { fprintf(stderr, "kernel_launch: hipFuncSetAttribute failed\n"); grid = -1; return; }
        if (hipOccupancyMaxActiveBlocksPerMultiprocessor(&per_cu, (const void*)fwd, NTHREADS, LDS_BYTES) != hipSuccess || per_cu < 1)
            fprintf(stderr, "kernel_launch: note: occupancy query reports %d workgroups per CU\n", per_cu);
        (void)hipGetLastError();
        grid = cus;
    }
    if (grid < 0) return;
    (void)hipMemsetAsync((char*)d_ws + WS_CTL, 0, CTL_ZERO_BYTES, stream);
    Args a{};
    for (int i = 0; i < N_IN; ++i) a.in[i] = d_in[i];
    a.out = (float*)d_out; a.ws = (unsigned char*)d_ws;
#if MK_PER_PHASE
    for (int p = 0; p < N_PHASES; ++p) { if (p == 1) continue; a.ph_lo = p; a.ph_hi = p + 1; hipLaunchKernelGGL(fwd, dim3(grid), dim3(NTHREADS), LDS_BYTES, stream, a); }
#else
    a.ph_lo = 0; a.ph_hi = N_PHASES;
    hipLaunchKernelGGL(fwd, dim3(grid), dim3(NTHREADS), LDS_BYTES, stream, a);
#endif
}
```

```cpp
#include <hip/hip_runtime.h>
#include <cstdio>
#include <cstdint>

#ifndef ABL
#define ABL 0
#endif
#ifndef MK_PER_PHASE
#define MK_PER_PHASE 0
#endif

#define LAS __attribute__((address_space(3)))
#define GAS __attribute__((address_space(1)))
typedef unsigned short bf16_t;
typedef short bf16x8 __attribute__((ext_vector_type(8)));
typedef float f32x4 __attribute__((ext_vector_type(4)));
typedef float f32x2 __attribute__((ext_vector_type(2)));
typedef unsigned u32x4 __attribute__((ext_vector_type(4)));
typedef unsigned u32x2 __attribute__((ext_vector_type(2)));

constexpr int NB = 8, SEQ = 4096, D = 1024, NTOK = NB * SEQ, DEPTH = 2;
constexpr int DIN = 2304, PS = 1792;
constexpr int P_U = 0, P_GV = 256, P_Q = 512, P_K = 768, P_V = 896, P_BX = 1024, P_CC = 1280, P_GLU = 1536;
constexpr int NEXP = 16, DEXP = 256, NBUCKET = 24;
constexpr int MPAD_MAX = NTOK + NBUCKET * 256;
constexpr float EPS = 1e-6f;

typedef __bf16 bf16x2_t __attribute__((ext_vector_type(2)));
__device__ __forceinline__ unsigned cvt_pk_bf16(float lo, float hi) { const bf16x2_t v = {(__bf16)lo, (__bf16)hi}; return __builtin_bit_cast(unsigned, v); }
__device__ __forceinline__ float bf_lo(unsigned w) { return __uint_as_float(w << 16); }
__device__ __forceinline__ float bf_hi(unsigned w) { return __uint_as_float(w & 0xffff0000u); }
__device__ __forceinline__ float bf2f(bf16_t h) { return __uint_as_float(((unsigned)h) << 16); }
__device__ __forceinline__ float sigmoid_f(float x) { return __builtin_amdgcn_rcpf(1.0f + __builtin_amdgcn_exp2f(-1.44269504089f * x)); }
__device__ __forceinline__ float gelu_tanh_f(float x) {
    const float t = x * (1.0f + 0.044715f * x * x); return x * sigmoid_f(1.5957691216f * t); }
__device__ __forceinline__ float silu_f(float x) { return x * sigmoid_f(x); }

__device__ __forceinline__ int lane_id_now() { int l; asm volatile("v_mbcnt_lo_u32_b32 %0, -1, 0\n\tv_mbcnt_hi_u32_b32 %0, -1, %0" : "=v"(l)); return l; }
template <int CTRL> __device__ __forceinline__ float dpp_f(float v) { return __int_as_float(__builtin_amdgcn_mov_dpp(__float_as_int(v), CTRL, 0xf, 0xf, true)); }
__device__ __forceinline__ float xor16_f(float v) { return __int_as_float(__builtin_amdgcn_ds_swizzle(__float_as_int(v), 0x401F)); }
__device__ __forceinline__ float sum_xor32_f(float v) { const auto r = __builtin_amdgcn_permlane32_swap(__float_as_uint(v), __float_as_uint(v), false, false); return __uint_as_float(r[0]) + __uint_as_float(r[1]); }
__device__ __forceinline__ float wave_sum(float v) {
    v += dpp_f<0xB1>(v); v += dpp_f<0x4E>(v); v += dpp_f<0x141>(v); v += dpp_f<0x140>(v);
    v += xor16_f(v); return sum_xor32_f(v);
}

namespace pg8 {
constexpr int BM = 256, BK = 64, HALF = 128, HTB = HALF * BK * 2  , STAGE_BYTES = 8 * HTB, NXCD = 8, WGM = 8;
__host__ __device__ __forceinline__ int lds_byte(int r, int c) { const int st = (r >> 4) * 2 + (c >> 5), rr = r & 15, cc = c & 31, ob = rr * 64 + cc * 2; return st * 1024 + (ob ^ (((ob >> 9) & 1) << 5)); }
__host__ __device__ __forceinline__ void stage_rc(int b, int& R, int& C) { const int st = b / 1024, sb = b % 1024, swz = sb ^ (((sb >> 9) & 1) << 5); R = (st >> 1) * 16 + swz / 64; C = (st & 1) * 32 + (swz % 64) / 2; }
__host__ __device__ __forceinline__ int perm32(int rho) { const int n = rho >> 4, i = rho & 15; return 8 * (i >> 2) + 4 * n + (i & 3); }

struct Unit { int pm, pn, aux; };

__device__ __forceinline__ void tile_of(int L, int nM, int nN, int& pm, int& pn) {
    const int nwg = nM * nN; int wgid = L; { const int q = nwg / NXCD, r = nwg % NXCD, xcd = wgid % NXCD, off = wgid / NXCD; wgid = (xcd < r ? xcd * (q + 1) : r * (q + 1) + (xcd - r) * q) + off; }
    const int nig = WGM * nN, gid = wgid / nig, fm = gid * WGM, gsz = (nM - fm) < WGM ? (nM - fm) : WGM;
    pm = fm + ((wgid % nig) % gsz); pn = (wgid % nig) / gsz;
}

template <class Epi, class Sched>
__device__ __forceinline__ void gemm_phase(LAS unsigned char* lds, const int wid  , const int K, const int lda, const int ldb, const Sched& S, const Epi& E) {
    const int lane = lane_id_now(), tid = wid * 64 + lane;
    const int wr = wid >> 2, wc = wid & 3, fr = lane & 15, fq = lane >> 4;
    int nt = K / BK; asm volatile("" : "+s"(nt));
    unsigned voffA[2], voffB[2];
#pragma unroll
    for (int i = 0; i < 2; ++i) { int R, C; stage_rc(tid * 16 + i * 8192, R, C); const int Rb = Epi::PERM ? ((R & ~31) + perm32(R & 31)) : R;
        voffA[i] = (unsigned)(R * lda + C) * 2u; voffB[i] = (unsigned)(Rb * ldb + C) * 2u; }
    asm volatile("" : "+v"(voffA[0]), "+v"(voffA[1]), "+v"(voffB[0]), "+v"(voffB[1]));
    const size_t kstep = (size_t)(BK * 2);
    const size_t hstepA = (size_t)HALF * lda * 2, hstepB = (size_t)HALF * ldb * 2;
    const unsigned ldsw = (unsigned)wid * 1024u;
    const int aoff = lds_byte(wr * 64 + fr, fq * 8), boff = lds_byte(wc * 32 + fr, fq * 8);
#define PG8_SA(b, h) (((b) * 2 + (h)) * HTB)
#define PG8_SB(b, h) ((4 + (b) * 2 + (h)) * HTB)
#define PG8_STAGE(bufoff, gbase, voff) do { _Pragma("unroll") for (int _i = 0; _i < 2; ++_i) \
        __builtin_amdgcn_global_load_lds((const unsigned*)((const char*)(gbase) + (voff)[_i]), (LAS unsigned*)(lds + (bufoff) + ldsw + _i * 8192), 16, 0, 0); } while (0)
#define PG8_LDA(dst, b, h) do { _Pragma("unroll") for (int m = 0; m < 4; ++m) _Pragma("unroll") for (int k = 0; k < 2; ++k) dst[m][k] = *(const LAS bf16x8*)(lds + PG8_SA(b, h) + aoff + m * 2048 + k * 1024); } while (0)
#define PG8_LDB(dst, b, h) do { _Pragma("unroll") for (int n = 0; n < 2; ++n) _Pragma("unroll") for (int k = 0; k < 2; ++k) dst[n][k] = *(const LAS bf16x8*)(lds + PG8_SB(b, h) + boff + n * 2048 + k * 1024); } while (0)
#define PG8_MMA(ai, bj, At, Bt) do { __builtin_amdgcn_s_setprio(1); _Pragma("unroll") for (int m = 0; m < 4; ++m) _Pragma("unroll") for (int n = 0; n < 2; ++n) _Pragma("unroll") for (int k = 0; k < 2; ++k) \
        acc[ai][bj][m][n] = __builtin_amdgcn_mfma_f32_16x16x32_bf16(Bt[n][k], At[m][k], acc[ai][bj][m][n], 0, 0, 0); __builtin_amdgcn_s_setprio(0); } while (0)
#define PG8_WAIT_V(n) asm volatile("s_waitcnt vmcnt(" #n ")" ::: "memory")
#define PG8_WAIT_L(n) asm volatile("s_waitcnt lgkmcnt(" #n ")" ::: "memory")
#define PG8_BAR __builtin_amdgcn_s_barrier()
#define PG8_SCHED __builtin_amdgcn_sched_barrier(0)
    Unit cur, nxt; int ui = 0;
    if (!S.next(0, cur)) return;
    f32x4 acc[2][2][4][2];
#pragma unroll
    for (int a = 0; a < 2; ++a)
#pragma unroll
        for (int b = 0; b < 2; ++b)
#pragma unroll
            for (int m = 0; m < 4; ++m)
#pragma unroll
                for (int n = 0; n < 2; ++n) acc[a][b][m][n] = (f32x4){0.f, 0.f, 0.f, 0.f};
    bf16x8 At[4][2], B0[2][2], B1[2][2];
    const char* cA = S.a_ptr(cur); const char* cB = S.b_ptr(cur);
    PG8_STAGE(PG8_SB(0, 0), cB, voffB); PG8_STAGE(PG8_SB(0, 1), cB + hstepB, voffB); PG8_STAGE(PG8_SA(0, 0), cA, voffA); PG8_STAGE(PG8_SA(0, 1), cA + hstepA, voffA);
    if (wr == 1) PG8_BAR;
    PG8_WAIT_V(2); PG8_BAR;
    PG8_STAGE(PG8_SB(1, 0), cB + kstep, voffB); PG8_STAGE(PG8_SA(1, 0), cA + kstep, voffA); PG8_STAGE(PG8_SB(1, 1), cB + hstepB + kstep, voffB);
    PG8_WAIT_V(6); PG8_BAR;
    for (;;) {
        if constexpr (Sched::VAR_K) { nt = S.nt(cur); asm volatile("" : "+s"(nt)); }
        const bool has_next = S.next(ui + 1, nxt);
        const char* nA = has_next ? S.a_ptr(nxt) : cA; const char* nB = has_next ? S.b_ptr(nxt) : cB;
        const char* cB2 = cB; int segT = nt;
        if constexpr (Sched::TWO_SEG) { segT = S.seg_tiles(); cB2 = S.b_ptr2(cur) - (size_t)segT * kstep; }
        for (int t = 0; t < nt; t += 2) {
            const bool last = (t == nt - 2);
            const char* a1 = cA + (size_t)(t + 1) * kstep;
            const char* bsrc = (t + 2 >= segT) ? cB2 : cB;
            const char* a2 = last ? nA : cA + (size_t)(t + 2) * kstep; const char* b2 = last ? nB : bsrc + (size_t)(t + 2) * kstep;
            const char* a3 = a2 + kstep; const char* b3 = b2 + kstep;
            PG8_LDB(B0, 0, 0); PG8_LDB(B1, 0, 1); PG8_SCHED; PG8_LDA(At, 0, 0); PG8_STAGE(PG8_SA(1, 1), a1 + hstepA, voffA);
            PG8_WAIT_V(8); PG8_WAIT_L(0); PG8_BAR; PG8_MMA(0, 0, At, B0); PG8_MMA(0, 1, At, B1); PG8_BAR; PG8_SCHED;
            PG8_LDA(At, 0, 1); PG8_STAGE(PG8_SB(0, 0), b2, voffB); PG8_STAGE(PG8_SB(0, 1), b2 + hstepB, voffB); PG8_STAGE(PG8_SA(0, 0), a2, voffA);
            PG8_WAIT_V(8); PG8_WAIT_L(0); PG8_BAR; PG8_MMA(1, 0, At, B0); PG8_MMA(1, 1, At, B1); PG8_BAR; PG8_SCHED;
            PG8_LDB(B0, 1, 0); PG8_LDB(B1, 1, 1); PG8_SCHED; PG8_LDA(At, 1, 0); PG8_STAGE(PG8_SA(0, 1), a2 + hstepA, voffA);
            PG8_WAIT_V(8); PG8_WAIT_L(0); PG8_BAR; PG8_MMA(0, 0, At, B0); PG8_MMA(0, 1, At, B1); PG8_BAR; PG8_SCHED;
            PG8_LDA(At, 1, 1); PG8_STAGE(PG8_SB(1, 0), b3, voffB); PG8_STAGE(PG8_SB(1, 1), b3 + hstepB, voffB); PG8_STAGE(PG8_SA(1, 0), a3, voffA);
            PG8_WAIT_V(8); PG8_WAIT_L(0); PG8_BAR; PG8_MMA(1, 0, At, B0); PG8_MMA(1, 1, At, B1); PG8_BAR; PG8_SCHED;
        }
        if (wr == 0) PG8_BAR;
        { const int le = lane_id_now(); E(acc, cur, wr, wc, le & 15, le >> 4); }
        if (!has_next) break;
#pragma unroll
        for (int a = 0; a < 2; ++a)
#pragma unroll
            for (int b = 0; b < 2; ++b)
#pragma unroll
                for (int m = 0; m < 4; ++m)
#pragma unroll
                    for (int n = 0; n < 2; ++n) acc[a][b][m][n] = (f32x4){0.f, 0.f, 0.f, 0.f};
        cur = nxt; cA = nA; cB = nB; ++ui;
        if (wr == 1) PG8_BAR;
    }
    PG8_WAIT_V(0);
    PG8_BAR;
#undef PG8_SA
#undef PG8_SB
#undef PG8_STAGE
#undef PG8_LDA
#undef PG8_LDB
#undef PG8_MMA
#undef PG8_WAIT_V
#undef PG8_WAIT_L
#undef PG8_BAR
#undef PG8_SCHED
}
}

constexpr size_t MiB = 1u << 20;
constexpr size_t WS_CTL = 0, CTL_ZERO_BYTES = 1 * MiB;
constexpr size_t WS_AUX = 1 * MiB;
constexpr size_t AUX_RS = WS_AUX, AUX_BKT = AUX_RS + 131072, AUX_WLO = AUX_BKT + 131072, AUX_WHI = AUX_WLO + 131072,
                 AUX_STOK = AUX_WHI + 131072, AUX_SW = AUX_STOK + 163840, AUX_TB = AUX_SW + 655360, AUX_BH = AUX_TB + 1024;
constexpr size_t WS_SGU = 2621440;
constexpr size_t WS_ROPE = 3 * MiB;
constexpr size_t WS_W = 5 * MiB;
constexpr size_t W_IN = 0, W_GATE = W_IN + (size_t)DIN * D * 2, W_BR = W_GATE + (size_t)4096 * D * 2, W_O = W_BR + (size_t)4 * D * 256 * 2,
                 W_GU = W_O + (size_t)D * D * 2, W_DN = W_GU + (size_t)NEXP * 512 * D * 2, W_LAYER = W_DN + (size_t)NEXP * D * 256 * 2;
constexpr size_t WS_BIG = 86 * MiB;
constexpr size_t BIG_GS = WS_BIG + 112 * MiB, BIG_MS = BIG_GS + 32 * MiB, BIG_MG = BIG_MS + 32 * MiB;
constexpr size_t BIG_X1 = WS_BIG, BIG_H2S = BIG_X1 + (size_t)NTOK * D * 4, BIG_HID = BIG_H2S + (size_t)MPAD_MAX * D * 2;
constexpr size_t WS_HM = 342 * MiB;
constexpr size_t WS_YS = 406 * MiB;
constexpr size_t WS_END = 470 * MiB;
static_assert(WS_W + 2 * W_LAYER <= WS_BIG && BIG_HID + (size_t)MPAD_MAX * 512 * 2 <= WS_HM && AUX_BH + 32768 <= WS_SGU && WS_SGU + 262144 <= WS_ROPE, "d_ws map");
constexpr int CW_BAR = 4096;
constexpr int CW_CNT = 8192;

constexpr int RING_BYTES = 131072;
constexpr int LDSCTL_OFF = RING_BYTES;
constexpr int LDS_BYTES = 147456;
constexpr int NWAVES = 8, NTHREADS = 512;

#define XB_TMO      128
#define XB_XCNT(j)  (256  + 64 * (j))
#define XB_XSUB(j)  (1280 + 64 * (j))
#define XB_XGEN(j)  (2304 + 64 * (j))
#define XB_TOP      3328
#define XB_TOPGEN   3392
#define XCD_BAR_WORDS 3456
#define XB_SPIN_CAP (1u << 18)

__device__ __forceinline__ unsigned xb_ld(unsigned* p)              { return __hip_atomic_load(p, __ATOMIC_RELAXED, __HIP_MEMORY_SCOPE_AGENT); }
__device__ __forceinline__ unsigned xb_add(unsigned* p, unsigned v) { return __hip_atomic_fetch_add(p, v, __ATOMIC_RELAXED, __HIP_MEMORY_SCOPE_AGENT); }
__device__ __forceinline__ unsigned xb_xcc_id() { return (unsigned)__builtin_amdgcn_s_getreg((3 << 11) | 20) & 0xFu; }
#define XB_SPIN(cond, bar) do { unsigned _sp = 0; while (cond) { __builtin_amdgcn_s_sleep(1); \
    if ((++_sp & 255u) == 0u) { if (xb_ld(&(bar)[XB_TMO])) break; if (_sp > XB_SPIN_CAP) { atomicAdd(&(bar)[XB_TMO], 1u); break; } } } } while (0)

struct XcdBarrier {
    unsigned* bar; unsigned x; int wave;
    volatile LAS unsigned* st;
};
__device__ __forceinline__ XcdBarrier xcd_barrier_post(unsigned* bar, volatile LAS unsigned* st) {
    XcdBarrier b; b.bar = bar; b.x = xb_xcc_id(); b.st = st; b.wave = __builtin_amdgcn_readfirstlane((int)threadIdx.x >> 6);
    if (threadIdx.x == 0) (void)xb_add(&bar[XB_XCNT(b.x)], 1u);
    return b;
}
__device__ __forceinline__ void xcd_barrier_complete(unsigned* bar, unsigned x, unsigned& nloc, unsigned& nx) {
    const unsigned G = gridDim.x * gridDim.y * gridDim.z;
    unsigned sum, cnt, mine, sp = 0u;
    for (;;) {
        sum = 0u; cnt = 0u; mine = 0u;
#pragma unroll
        for (unsigned j = 0; j < 16; ++j) { const unsigned c = xb_ld(&bar[XB_XCNT(j)]); sum += c; cnt += (c > 0u) ? 1u : 0u; mine = (j == x) ? c : mine; }
        if (sum == G) break;
        __builtin_amdgcn_s_sleep(1);
        if ((++sp & 255u) == 0u) { if (xb_ld(&bar[XB_TMO])) break; if (sp > XB_SPIN_CAP) { atomicAdd(&bar[XB_TMO], 1u); break; } }
    }
    nloc = mine > 0u ? mine : 1u; nx = cnt > 0u ? cnt : 1u;
}
__device__ __forceinline__ void xcd_barrier(const XcdBarrier& b) {
    asm volatile("s_waitcnt vmcnt(0)" ::: "memory");
    __syncthreads();
    if (b.wave == 0 && lane_id_now() == 0) {
        unsigned* bar = b.bar;
        __builtin_amdgcn_s_waitcnt(0);
        unsigned nloc = b.st[0], nx = b.st[1];
        if (nloc == 0u) { xcd_barrier_complete(bar, b.x, nloc, nx); b.st[0] = nloc; b.st[1] = nx; }
        const unsigned old = xb_add(&bar[XB_XSUB(b.x)], 1u);
        const unsigned gen = old / nloc;
        if (old + 1u == (gen + 1u) * nloc) {
            __builtin_amdgcn_fence(__ATOMIC_RELEASE, "agent");
            asm volatile("s_waitcnt vmcnt(0)" ::: "memory");
            const unsigned og = xb_add(&bar[XB_TOP], 1u);
            const unsigned tg = og / nx;
            if (og + 1u == (tg + 1u) * nx) xb_add(&bar[XB_TOPGEN], 1u);
            else XB_SPIN(xb_ld(&bar[XB_TOPGEN]) == tg, bar);
            __builtin_amdgcn_fence(__ATOMIC_ACQUIRE, "agent");
            xb_add(&bar[XB_XGEN(b.x)], 1u);
            asm volatile("s_waitcnt vmcnt(0)" ::: "memory");
        } else {
            XB_SPIN(xb_ld(&bar[XB_XGEN(b.x)]) == gen, bar);
            __builtin_amdgcn_fence(__ATOMIC_ACQUIRE, "agent");
            asm volatile("s_waitcnt vmcnt(0)" ::: "memory");
        }
    }
    __syncthreads();
}

struct PlainOrder {
    static constexpr bool TWO_SEG = false, VAR_K = false;
    const char* A; const char* Bt; int nM, nN, G, c; size_t tA, tB;
    __device__ __forceinline__ bool next(int i, pg8::Unit& u) const { const int L = i * G + c; if (L >= nM * nN) return false; pg8::tile_of(L, nM, nN, u.pm, u.pn); u.aux = 0; return true; }
    __device__ __forceinline__ const char* a_ptr(const pg8::Unit& u) const { return A + (size_t)u.pm * tA; }
    __device__ __forceinline__ const char* b_ptr(const pg8::Unit& u) const { return Bt + (size_t)u.pn * tB; }
};
struct BranchOrder {
    static constexpr bool TWO_SEG = false, VAR_K = false;
    const char* ys; const char* wb; int G, c;
    __device__ __forceinline__ bool next(int i, pg8::Unit& u) const { const int L = (i >> 2) * G + c; if (L >= 128 * 4) return false; pg8::tile_of(L, 128, 4, u.pm, u.pn); u.aux = i & 3; return true; }
    __device__ __forceinline__ const char* a_ptr(const pg8::Unit& u) const { return ys + (size_t)u.pm * (256 * 1024 * 2) + (size_t)u.aux * 512; }
    __device__ __forceinline__ const char* b_ptr(const pg8::Unit& u) const { return wb + (size_t)(u.aux * 1024 + u.pn * 256) * 512; }
};
struct GateMergeOrder {
    static constexpr bool TWO_SEG = false, VAR_K = true;
    const char* h; const char* ys; const char* wg; const char* wb; int G, c;
    __device__ __forceinline__ bool next(int i, pg8::Unit& u) const { const int L = (i >> 3) * G + c; if (L >= 128 * 4) return false; pg8::tile_of(L, 128, 4, u.pm, u.pn); u.aux = ((i >> 1) & 3) | ((i & 1) << 2); return true; }
    __device__ __forceinline__ int nt(const pg8::Unit& u) const { return (u.aux & 4) ? 4 : 16; }
    __device__ __forceinline__ const char* a_ptr(const pg8::Unit& u) const { return (u.aux & 4) ? ys + (size_t)u.pm * (256 * 1024 * 2) + (size_t)(u.aux & 3) * 512 : h + (size_t)u.pm * (256 * 1024 * 2); }
    __device__ __forceinline__ const char* b_ptr(const pg8::Unit& u) const { return (u.aux & 4) ? wb + (size_t)u.pn * (256 * 1024 * 2) + (size_t)(u.aux & 3) * 512 : wg + (size_t)((u.aux & 3) * 1024 + u.pn * 256) * 2048; }
};
__device__ __forceinline__ void bucket_experts(int bucket, int& e1, int& e2) {
    const int g = bucket / 6, pr = bucket - 6 * g;
    const int a = pr < 3 ? 0 : (pr < 5 ? 1 : 2), b = pr < 3 ? pr + 1 : (pr < 5 ? pr - 1 : 3);
    e1 = 4 * g + a; e2 = 4 * g + b;
}
struct MoeUpOrder {
    static constexpr bool TWO_SEG = false, VAR_K = false;
    const char* h2s; const char* wgu; unsigned* tile_bucket; int nTiles, G, vcu;
    __device__ __forceinline__ bool next(int i, pg8::Unit& u) const { const int L = i * G + vcu; if (L >= nTiles * 4) return false; u.pm = L >> 2; u.pn = L & 3;
        u.aux = __builtin_amdgcn_readfirstlane((int)__hip_atomic_load(tile_bucket + u.pm, __ATOMIC_RELAXED, __HIP_MEMORY_SCOPE_AGENT)); return true; }
    __device__ __forceinline__ const char* a_ptr(const pg8::Unit& u) const { return h2s + (size_t)u.pm * (256 * 1024 * 2); }
    __device__ __forceinline__ const char* b_ptr(const pg8::Unit& u) const { int e1, e2; bucket_experts(u.aux, e1, e2); const int e = u.pn < 2 ? e1 : e2; return wgu + (size_t)(e * 512 + (u.pn & 1) * 256) * 2048; }
};
struct MoeDownOrder {
    static constexpr bool TWO_SEG = true, VAR_K = false;
    const char* hid; const char* wdn; unsigned* tile_bucket; int nTiles, G, vcu;
    __device__ __forceinline__ bool next(int i, pg8::Unit& u) const { const int L = i * G + vcu; if (L >= nTiles * 4) return false; u.pm = L >> 2; u.pn = L & 3;
        u.aux = __builtin_amdgcn_readfirstlane((int)__hip_atomic_load(tile_bucket + u.pm, __ATOMIC_RELAXED, __HIP_MEMORY_SCOPE_AGENT)); return true; }
    __device__ __forceinline__ int seg_tiles() const { return 4; }
    __device__ __forceinline__ const char* a_ptr(const pg8::Unit& u) const { return hid + (size_t)u.pm * (256 * 512 * 2); }
    __device__ __forceinline__ const char* b_ptr(const pg8::Unit& u) const { int e1, e2; bucket_experts(u.aux, e1, e2); return wdn + (size_t)(e1 * 1024 + u.pn * 256) * 512; }
    __device__ __forceinline__ const char* b_ptr2(const pg8::Unit& u) const { int e1, e2; bucket_experts(u.aux, e1, e2); return wdn + (size_t)(e2 * 1024 + u.pn * 256) * 512; }
};

typedef f32x4 Acc[2][2][4][2];
__device__ __forceinline__ u32x4 pack8(const f32x4 a, const f32x4 b) { u32x4 w; w.x = cvt_pk_bf16(a[0], a[1]); w.y = cvt_pk_bf16(a[2], a[3]); w.z = cvt_pk_bf16(b[0], b[1]); w.w = cvt_pk_bf16(b[2], b[3]); return w; }
__device__ __forceinline__ void unpack8(const u32x4 w, f32x4& a, f32x4& b) { a = (f32x4){bf_lo(w.x), bf_hi(w.x), bf_lo(w.y), bf_hi(w.y)}; b = (f32x4){bf_lo(w.z), bf_hi(w.z), bf_lo(w.w), bf_hi(w.w)}; }

struct EpiInProj {
    static constexpr bool PERM = true;
    bf16_t* P; const float* rope; const float* qg; const float* kg;
    __device__ __forceinline__ void operator()(const Acc& acc, const pg8::Unit& u, int wr, int wc, int fr, int fq) const {
        asm volatile("" : "+v"(fr), "+v"(fq));
        const int pn = u.pn, row0 = u.pm * 256 + wr * 64 + fr, c8 = wc * 32 + 8 * fq;
        if (pn == 2 || (pn == 3 && wc < 2)) {
            const float* gp = (pn == 2) ? qg : kg; const float osc = (pn == 2) ? 0.125f : 1.0f;
            f32x4 g[2][2];
#pragma unroll
            for (int bj = 0; bj < 2; ++bj)
#pragma unroll
                for (int n = 0; n < 2; ++n) g[bj][n] = *(const f32x4*)(gp + bj * 32 + 8 * fq + 4 * n);
            const int dcol = (pn == 2 ? P_Q : P_K) + wc * 64 + 8 * fq;
#pragma unroll
            for (int ai = 0; ai < 2; ++ai)
#pragma unroll
                for (int m = 0; m < 4; ++m) {
                    const int row = row0 + ai * 128 + m * 16;
                    float ss = 0.f;
#pragma unroll
                    for (int bj = 0; bj < 2; ++bj)
#pragma unroll
                        for (int n = 0; n < 2; ++n) { const f32x4 v = acc[ai][bj][m][n]; ss += (v[0] * v[0] + v[1] * v[1]) + (v[2] * v[2] + v[3] * v[3]); }
                    ss += xor16_f(ss); ss = sum_xor32_f(ss);
                    const float rs = __builtin_amdgcn_rsqf(ss * (1.0f / 64.0f) + EPS);
                    f32x4 o[2][2];
#pragma unroll
                    for (int bj = 0; bj < 2; ++bj)
#pragma unroll
                        for (int n = 0; n < 2; ++n) o[bj][n] = acc[ai][bj][m][n] * rs * g[bj][n];
                    const float* rp = rope + (size_t)row * 16;
#pragma unroll
                    for (int n = 0; n < 2; ++n) {
                        const f32x4 cs = *(const f32x4*)(rp + 4 * n), sn = *(const f32x4*)(rp + 8 + 4 * n);
                        f32x4 other;
#pragma unroll
                        for (int j = 0; j < 4; ++j) other[j] = xor16_f(o[0][n][j]);
                        const f32x4 rot = (fq == 0) ? (o[0][n] * cs - other * sn) : (o[0][n] * cs + other * sn);
                        if (fq < 2) o[0][n] = rot;
                    }
#pragma unroll
                    for (int bj = 0; bj < 2; ++bj) *(u32x4*)(P + (size_t)row * PS + dcol + bj * 32) = pack8(o[bj][0] * osc, o[bj][1] * osc);
                }
            return;
        }
#pragma unroll
        for (int ai = 0; ai < 2; ++ai)
#pragma unroll
            for (int m = 0; m < 4; ++m) {
                bf16_t* prow = P + (size_t)(row0 + ai * 128 + m * 16) * PS;
                const f32x4 a0 = acc[ai][0][m][0], a1 = acc[ai][0][m][1], b0 = acc[ai][1][m][0], b1 = acc[ai][1][m][1];
                if (pn < 2) {
                    f32x4 x0, x1, y0, y1;
#pragma unroll
                    for (int j = 0; j < 4; ++j) { x0[j] = gelu_tanh_f(a0[j]); x1[j] = gelu_tanh_f(a1[j]); y0[j] = gelu_tanh_f(b0[j]); y1[j] = gelu_tanh_f(b1[j]); }
                    *(u32x4*)(prow + pn * 256 + c8) = pack8(x0, x1); *(u32x4*)(prow + pn * 256 + 128 + c8) = pack8(y0, y1);
                } else if (pn == 3) {
                    const int dc = P_V + (wc - 2) * 64 + 8 * fq;
                    *(u32x4*)(prow + dc) = pack8(a0, a1); *(u32x4*)(prow + dc + 32) = pack8(b0, b1);
                } else if (pn == 4 || pn == 5) {
                    *(u32x4*)(prow + P_BX + (pn - 4) * 128 + c8) = pack8(a0 * b0, a1 * b1);
                } else if (pn == 6) {
                    *(u32x4*)(prow + P_CC + c8) = pack8(a0, a1); *(u32x4*)(prow + P_CC + 128 + c8) = pack8(b0, b1);
                } else {
                    f32x4 x0, x1;
#pragma unroll
                    for (int j = 0; j < 4; ++j) { x0[j] = a0[j] * sigmoid_f(b0[j]); x1[j] = a1[j] * sigmoid_f(b1[j]); }
                    *(u32x4*)(prow + P_GLU + (pn - 7) * 128 + c8) = pack8(x0, x1);
                }
            }
    }
};
struct EpiGate {
    static constexpr bool PERM = true;
    bf16_t* Gm; const float* bias;
    __device__ __forceinline__ void operator()(const Acc& acc, const pg8::Unit& u, int wr, int wc, int fr, int fq) const {
        asm volatile("" : "+v"(fr), "+v"(fq));
        const int row0 = u.pm * 256 + wr * 64 + fr, col0 = u.pn * 256 + wc * 32 + 8 * fq;
        f32x4 bv[2][2];
#pragma unroll
        for (int bj = 0; bj < 2; ++bj)
#pragma unroll
            for (int n = 0; n < 2; ++n) bv[bj][n] = *(const f32x4*)(bias + col0 + bj * 128 + 4 * n);
#pragma unroll
        for (int ai = 0; ai < 2; ++ai)
#pragma unroll
            for (int m = 0; m < 4; ++m) { bf16_t* rowp = Gm + (size_t)(row0 + ai * 128 + m * 16) * 4096 + col0;
#pragma unroll
                for (int bj = 0; bj < 2; ++bj) { f32x4 v0 = acc[ai][bj][m][0] + bv[bj][0], v1 = acc[ai][bj][m][1] + bv[bj][1];
#pragma unroll
                    for (int j = 0; j < 4; ++j) { v0[j] = sigmoid_f(v0[j]); v1[j] = sigmoid_f(v1[j]); }
                    *(u32x4*)(rowp + bj * 128) = pack8(v0, v1); } }
    }
};
struct EpiMerge {
    static constexpr bool PERM = true;
    const bf16_t* Gm; bf16_t* Mg;
    __device__ __forceinline__ void operator()(const Acc& acc, const pg8::Unit& u, int wr, int wc, int fr, int fq) const {
        asm volatile("" : "+v"(fr), "+v"(fq));
        const int row0 = u.pm * 256 + wr * 64 + fr, col0 = u.pn * 256 + wc * 32 + 8 * fq, b = u.aux;
#pragma unroll
        for (int ai = 0; ai < 2; ++ai)
#pragma unroll
            for (int m = 0; m < 4; ++m) { const unsigned row = (unsigned)(row0 + ai * 128 + m * 16);
#pragma unroll
                for (int bj = 0; bj < 2; ++bj) {
                    f32x4 g0, g1; unpack8(*(const u32x4*)(Gm + (row * 4096u + (unsigned)(b * 1024 + col0 + bj * 128))), g0, g1);
                    f32x4 v0 = acc[ai][bj][m][0] * g0, v1 = acc[ai][bj][m][1] * g1;
                    bf16_t* mp = Mg + (row * 1024u + (unsigned)(col0 + bj * 128));
                    if (b > 0) {
                        const unsigned long long q0 = __hip_atomic_load((const unsigned long long*)mp, __ATOMIC_RELAXED, __HIP_MEMORY_SCOPE_AGENT), q1 = __hip_atomic_load((const unsigned long long*)mp + 1, __ATOMIC_RELAXED, __HIP_MEMORY_SCOPE_AGENT);
                        f32x4 p0, p1; unpack8((u32x4){(unsigned)q0, (unsigned)(q0 >> 32), (unsigned)q1, (unsigned)(q1 >> 32)}, p0, p1); v0 += p0; v1 += p1; }
                    *(u32x4*)mp = pack8(v0, v1); }
                asm volatile("" ::: "memory"); }
    }
};
__device__ __forceinline__ u32x4 ld16_nt(const bf16_t* p) { return __builtin_nontemporal_load((const u32x4*)p); }
__device__ __forceinline__ u32x4 ld16_sc1(const bf16_t* p) { const unsigned long long a = __hip_atomic_load((const unsigned long long*)p, __ATOMIC_RELAXED, __HIP_MEMORY_SCOPE_AGENT), b = __hip_atomic_load((const unsigned long long*)p + 1, __ATOMIC_RELAXED, __HIP_MEMORY_SCOPE_AGENT);
    return (u32x4){(unsigned)a, (unsigned)(a >> 32), (unsigned)b, (unsigned)(b >> 32)}; }
struct EpiGateMerge {
    static constexpr bool PERM = true;
    bf16_t* Gs; bf16_t* Ms; bf16_t* Mg; const float* bias;
    __device__ __forceinline__ void operator()(const Acc& acc, const pg8::Unit& u, int wr, int wc, int fr, int fq) const {
        asm volatile("" : "+v"(fr), "+v"(fq));
        const int b = u.aux & 3, tid = (wr * 4 + wc) * 64 + fq * 16 + fr;
        if (!(u.aux & 4)) {
            const int col0 = b * 1024 + u.pn * 256 + wc * 32 + 8 * fq;
            f32x4 bv[2][2];
#pragma unroll
            for (int bj = 0; bj < 2; ++bj)
#pragma unroll
                for (int n = 0; n < 2; ++n) bv[bj][n] = *(const f32x4*)(bias + col0 + bj * 128 + 4 * n);
#pragma unroll
            for (int ai = 0; ai < 2; ++ai)
#pragma unroll
                for (int m = 0; m < 4; ++m)
#pragma unroll
                    for (int bj = 0; bj < 2; ++bj) { f32x4 v0 = acc[ai][bj][m][0] + bv[bj][0], v1 = acc[ai][bj][m][1] + bv[bj][1];
#pragma unroll
                        for (int j = 0; j < 4; ++j) { v0[j] = sigmoid_f(v0[j]); v1[j] = sigmoid_f(v1[j]); }
                        *(u32x4*)(Gs + ((((ai * 4 + m) * 2 + bj) * 512 + tid) * 8)) = pack8(v0, v1); }
        } else {
            const int row0 = u.pm * 256 + wr * 64 + fr, col0 = u.pn * 256 + wc * 32 + 8 * fq;
#pragma unroll
            for (int ai = 0; ai < 2; ++ai) {
                u32x4 gq[4][2], pq[4][2];
#pragma unroll
                for (int m = 0; m < 4; ++m)
#pragma unroll
                    for (int bj = 0; bj < 2; ++bj) { const int ch = (((ai * 4 + m) * 2 + bj) * 512 + tid) * 8; gq[m][bj] = ld16_nt(Gs + ch); if (b > 0) pq[m][bj] = ld16_nt(Ms + ch); }
#pragma unroll
                for (int m = 0; m < 4; ++m)
#pragma unroll
                    for (int bj = 0; bj < 2; ++bj) { const int ch = (((ai * 4 + m) * 2 + bj) * 512 + tid) * 8;
                        f32x4 g0, g1; unpack8(gq[m][bj], g0, g1);
                        f32x4 v0 = acc[ai][bj][m][0] * g0, v1 = acc[ai][bj][m][1] * g1;
                        if (b > 0) { f32x4 p0, p1; unpack8(pq[m][bj], p0, p1); v0 += p0; v1 += p1; }
                        if (b < 3) *(u32x4*)(Ms + ch) = pack8(v0, v1);
                        else *(u32x4*)(Mg + ((unsigned)(row0 + ai * 128 + m * 16) * 1024u + (unsigned)(col0 + bj * 128))) = pack8(v0, v1); }
                asm volatile("" ::: "memory"); }
        }
    }
};
struct EpiWo {
    static constexpr bool PERM = true;
    const float* xin; float* x1;
    __device__ __forceinline__ void operator()(const Acc& acc, const pg8::Unit& u, int wr, int wc, int fr, int fq) const {
        asm volatile("" : "+v"(fr), "+v"(fq));
        const int row0 = u.pm * 256 + wr * 64 + fr, col0 = u.pn * 256 + wc * 32 + 8 * fq;
#pragma unroll
        for (int ai = 0; ai < 2; ++ai) {
            f32x4 xr[4][2][2];
#pragma unroll
            for (int m = 0; m < 4; ++m)
#pragma unroll
                for (int bj = 0; bj < 2; ++bj)
#pragma unroll
                    for (int n = 0; n < 2; ++n) xr[m][bj][n] = *(const f32x4*)(xin + ((unsigned)(row0 + ai * 128 + m * 16) * 1024u + (unsigned)(col0 + bj * 128 + 4 * n)));
#pragma unroll
            for (int m = 0; m < 4; ++m)
#pragma unroll
                for (int bj = 0; bj < 2; ++bj)
#pragma unroll
                    for (int n = 0; n < 2; ++n) *(f32x4*)(x1 + ((unsigned)(row0 + ai * 128 + m * 16) * 1024u + (unsigned)(col0 + bj * 128 + 4 * n))) = xr[m][bj][n] + acc[ai][bj][m][n];
            asm volatile("" ::: "memory"); }
    }
};
struct EpiMoeUp {
    static constexpr bool PERM = true;
    bf16_t* hid; const float* slot_w;
    __device__ __forceinline__ void operator()(const Acc& acc, const pg8::Unit& u, int wr, int wc, int fr, int fq) const {
        asm volatile("" : "+v"(fr), "+v"(fq));
        const int row0 = u.pm * 256 + wr * 64 + fr, col0 = (u.pn >> 1) * 256 + (u.pn & 1) * 128 + wc * 32 + 8 * fq, k = u.pn >> 1;
#pragma unroll
        for (int ai = 0; ai < 2; ++ai)
#pragma unroll
            for (int m = 0; m < 4; ++m) { const size_t row = (size_t)(row0 + ai * 128 + m * 16); const f32x4 sw = *(const f32x4*)(slot_w + row * 4); const float w = (k ? sw[1] : sw[0]) * sw[2] * sw[2], rs = sw[2];
                f32x4 x0, x1; const f32x4 a0 = acc[ai][0][m][0], a1 = acc[ai][0][m][1], b0 = acc[ai][1][m][0], b1 = acc[ai][1][m][1];
#pragma unroll
                for (int j = 0; j < 4; ++j) { x0[j] = a0[j] * sigmoid_f(a0[j] * rs) * b0[j] * w; x1[j] = a1[j] * sigmoid_f(a1[j] * rs) * b1[j] * w; }
                *(u32x4*)(hid + row * 512 + col0) = pack8(x0, x1); }
    }
};
struct EpiMoeDown {
    static constexpr bool PERM = true;
    const int* slot_tok; const float* x1; float* out;
    __device__ __forceinline__ void operator()(const Acc& acc, const pg8::Unit& u, int wr, int wc, int fr, int fq) const {
        asm volatile("" : "+v"(fr), "+v"(fq));
        const int row0 = u.pm * 256 + wr * 64 + fr, col0 = u.pn * 256 + wc * 32 + 8 * fq;
        int tk[2][4];
#pragma unroll
        for (int ai = 0; ai < 2; ++ai)
#pragma unroll
            for (int m = 0; m < 4; ++m) tk[ai][m] = slot_tok[row0 + ai * 128 + m * 16];
#pragma unroll
        for (int ai = 0; ai < 2; ++ai) {
            f32x4 xr[4][2][2];
#pragma unroll
            for (int m = 0; m < 4; ++m) { const unsigned ro = (unsigned)(tk[ai][m] < 0 ? 0 : tk[ai][m]) * 1024u + (unsigned)col0;
#pragma unroll
                for (int bj = 0; bj < 2; ++bj)
#pragma unroll
                    for (int n = 0; n < 2; ++n) xr[m][bj][n] = *(const f32x4*)(x1 + (ro + bj * 128 + 4 * n)); }
#pragma unroll
            for (int m = 0; m < 4; ++m) if (tk[ai][m] >= 0) { const unsigned ro = (unsigned)tk[ai][m] * 1024u + (unsigned)col0;
#pragma unroll
                for (int bj = 0; bj < 2; ++bj)
#pragma unroll
                    for (int n = 0; n < 2; ++n) *(f32x4*)(out + (ro + bj * 128 + 4 * n)) = xr[m][bj][n] + ((ABL & 16) ? acc[ai][bj][m][n] * 0.f : acc[ai][bj][m][n]); }
            asm volatile("" ::: "memory"); }
    }
};

enum InIdx { I_X = 0, I_POS, I_N1G, I_WIN, I_SLNG, I_SLNB, I_SGUW, I_SGUB, I_QNG, I_KNG, I_SINK, I_C3W, I_C31W, I_C31B, I_CNG, I_CNB, I_WBR, I_WGATE, I_BGATE, I_WO,
             I_N2G, I_WGRP, I_BGRP, I_WEXP, I_BEXP, I_WEG, I_WEU, I_WED, N_IN };
struct Args { const void* in[N_IN]; float* out; unsigned char* ws; int ph_lo, ph_hi; };
struct Frame {
    LAS unsigned char* lds; unsigned char* ws; unsigned* ctl;
    int tid, lane, wave, vcu, G;
};
#define LDS_WAIT() asm volatile("s_waitcnt lgkmcnt(0)" ::: "memory")

__device__ __forceinline__ void p0_transpose_item(const float* W, int N, bf16_t* WT, int Kd, int k0, int n0, int drow0, LAS float* scr, int lane, int kd0 = -1, const float* ksc = nullptr) {
    if (kd0 < 0) kd0 = k0;
#pragma unroll 8
    for (int i = 0; i < 32; ++i) { const int kk = 2 * i + (lane >> 5); const float sc = ksc ? ksc[k0 + kk] : 1.0f; scr[kk * 33 + (lane & 31)] = W[(size_t)(k0 + kk) * N + n0 + (lane & 31)] * sc; }
    LDS_WAIT(); asm volatile("" ::: "memory");
    const int c = lane & 7;
#pragma unroll
    for (int j = 0; j < 4; ++j) { const int n = (lane >> 3) + 8 * j; const LAS float* s = scr + (8 * c) * 33 + n;
        u32x4 o; o.x = cvt_pk_bf16(s[0 * 33], s[1 * 33]); o.y = cvt_pk_bf16(s[2 * 33], s[3 * 33]); o.z = cvt_pk_bf16(s[4 * 33], s[5 * 33]); o.w = cvt_pk_bf16(s[6 * 33], s[7 * 33]);
        *(u32x4*)(WT + (size_t)(drow0 + n) * Kd + kd0 + 8 * c) = o; }
    LDS_WAIT(); asm volatile("" ::: "memory");
}
__device__ __forceinline__ int win_dest_row(int s0) {
    if (s0 < 512) return s0;
    if (s0 < 768)  { const int r = s0 - 512, h = r >> 6, bj = (r >> 5) & 1; return 512 + 128 * bj + 32 * h; }
    if (s0 < 896)  { const int r = s0 - 768, h = r >> 6, bj = (r >> 5) & 1; return 768 + 128 * bj + 32 * h; }
    if (s0 < 1024) { const int r = s0 - 896, h = r >> 6, bj = (r >> 5) & 1; return 768 + 128 * bj + 32 * (h + 2); }
    if (s0 < 1280) { const int ch = s0 - 1024; return (4 + (ch >> 7)) * 256 + (ch & 127); }
    if (s0 < 1536) return 6 * 256 + (s0 - 1280);
    if (s0 < 1792) { const int ch = s0 - 1536; return (4 + (ch >> 7)) * 256 + 128 + (ch & 127); }
    if (s0 < 2048) { const int ch = s0 - 1792; return (7 + (ch >> 7)) * 256 + (ch & 127); }
    { const int ch = s0 - 2048; return (7 + (ch >> 7)) * 256 + 128 + (ch & 127); }
}
constexpr int IT_WIN = 16 * 72, IT_WGATE = 16 * 128, IT_WBR = 4 * 4 * 32, IT_WO = 16 * 32, IT_EG = 16 * 16 * 8, IT_EU = IT_EG, IT_ED = 16 * 4 * 32;
constexpr int IT_LAYER = IT_WIN + IT_WGATE + IT_WBR + IT_WO + IT_EG + IT_EU + IT_ED;
__device__ __forceinline__ void p0_weights(const Frame& F0, const Args& a) {
    Frame F = F0; F.lane = lane_id_now(); F.tid = F.wave * 64 + F.lane; asm volatile("" : "+s"(F.G), "+s"(F.vcu));
    LAS float* scr = (LAS float*)(F.lds + F.wave * 16384);
    const int gw = F.vcu * NWAVES + F.wave, NGW = F.G * NWAVES;
    for (int it = gw; it < DEPTH * IT_LAYER; it += NGW) {
        const int l = it / IT_LAYER; int r = it - l * IT_LAYER;
        unsigned char* wl = F.ws + WS_W + (size_t)l * W_LAYER;
        if (r < IT_WIN) { const int kb = r / 72, nb = r % 72; p0_transpose_item((const float*)a.in[I_WIN] + (size_t)l * D * DIN, DIN, (bf16_t*)(wl + W_IN), D, 64 * kb, 32 * nb, win_dest_row(32 * nb), scr, F.lane); continue; } r -= IT_WIN;
        if (r < IT_WGATE) { const int kb = r / 128, nb = r % 128; p0_transpose_item((const float*)a.in[I_WGATE] + (size_t)l * D * 4096, 4096, (bf16_t*)(wl + W_GATE), D, 64 * kb, 32 * nb, 32 * nb, scr, F.lane); continue; } r -= IT_WGATE;
        if (r < IT_WBR) { const int b = r / 128, q = r % 128, kb = q / 32, nb = q % 32; p0_transpose_item((const float*)a.in[I_WBR] + ((size_t)l * 4 + b) * 256 * D, D, (bf16_t*)(wl + W_BR), 1024, 64 * kb, 32 * nb, 32 * nb, scr, F.lane, b * 256 + 64 * kb); continue; } r -= IT_WBR;
        if (r < IT_WO) { const int kb = r / 32, nb = r % 32; p0_transpose_item((const float*)a.in[I_WO] + (size_t)l * D * D, D, (bf16_t*)(wl + W_O), D, 64 * kb, 32 * nb, 32 * nb, scr, F.lane); continue; } r -= IT_WO;
        if (r < IT_EG + IT_EU) { const int up = r >= IT_EG; if (up) r -= IT_EG; const int e = r / 128, q = r % 128, kb = q / 8, nb = q % 8, f0 = 32 * nb;
            const float* src = (const float*)a.in[up ? I_WEU : I_WEG] + ((size_t)l * NEXP + e) * D * DEXP;
            p0_transpose_item(src, DEXP, (bf16_t*)(wl + W_GU), D, 64 * kb, f0, e * 512 + (f0 >> 7) * 256 + up * 128 + (f0 & 127), scr, F.lane, -1, (const float*)a.in[I_N2G] + (size_t)l * D); continue; } r -= IT_EG + IT_EU;
        { const int e = r / 128, q = r % 128, kb = q / 32, nb = q % 32;
          p0_transpose_item((const float*)a.in[I_WED] + ((size_t)l * NEXP + e) * DEXP * D, D, (bf16_t*)(wl + W_DN), DEXP, 64 * kb, 32 * nb, e * 1024 + 32 * nb, scr, F.lane); }
    }
    const int gt = F.vcu * NTHREADS + F.tid, NGT = F.G * NTHREADS;
    float* rope = (float*)(F.ws + WS_ROPE); const int* pos = (const int*)a.in[I_POS];
    for (int idx = gt; idx < NTOK * 8; idx += NGT) { const int t = idx >> 3, i = idx & 7;
        const float inv = (float)exp2(-(double)i * (18.931568569324174 / 8.0));
        const float ang = (float)pos[t] * inv; float s, c; sincosf(ang, &s, &c);
        rope[(size_t)t * 16 + i] = c; rope[(size_t)t * 16 + 8 + i] = s; }
    bf16_t* sg = (bf16_t*)(F.ws + WS_SGU); const float* sw = (const float*)a.in[I_SGUW];
    for (int idx = gt; idx < DEPTH * 4 * 128 * 128 / 2; idx += NGT) { const int e = idx * 2, s = e & 127, t = (e >> 7) & 127;
        const float v0 = (s <= t) ? sw[e] : 0.f, v1 = (s + 1 <= t) ? sw[e + 1] : 0.f; ((unsigned*)sg)[idx] = cvt_pk_bf16(v0, v1); }
}
__device__ __forceinline__ void norm_rows(const Frame& F0, const float* x, const float* g, bf16_t* h) {
    Frame F = F0; F.lane = lane_id_now(); F.tid = F.wave * 64 + F.lane; asm volatile("" : "+s"(F.G), "+s"(F.vcu));
    const int gw = F.vcu * NWAVES + F.wave, NGW = F.G * NWAVES;
    f32x4 gv[4];
#pragma unroll
    for (int j = 0; j < 4; ++j) gv[j] = *((const f32x4*)g + F.lane + 64 * j);
    for (int m = gw; m < NTOK; m += NGW) {
        const f32x4* xr = (const f32x4*)(x + (size_t)m * D) + F.lane;
        f32x4 v[4]; float s = 0.f;
#pragma unroll
        for (int j = 0; j < 4; ++j) { v[j] = xr[64 * j]; s += (v[j][0] * v[j][0] + v[j][1] * v[j][1]) + (v[j][2] * v[j][2] + v[j][3] * v[j][3]); }
        const float rs = 1.0f / sqrtf(wave_sum(s) * (1.0f / D) + EPS);
        u32x2* o8 = (u32x2*)(h + (size_t)m * D) + F.lane;
#pragma unroll
        for (int j = 0; j < 4; ++j) { const f32x4 y = v[j] * rs * gv[j]; u32x2 o; o.x = cvt_pk_bf16(y[0], y[1]); o.y = cvt_pk_bf16(y[2], y[3]); o8[64 * j] = o; }
    }
}

struct MixArgs { const bf16_t* P; bf16_t* ys; const bf16_t* sgw; const float *sln_g, *sln_b, *sgu_w, *sgu_b, *sinks, *c3w, *c31w, *c31b, *cn_g, *cn_b; };

typedef float f32x16 __attribute__((ext_vector_type(16)));
__device__ __forceinline__ float max_xor32_f(float v) { const auto r = __builtin_amdgcn_permlane32_swap(__float_as_uint(v), __float_as_uint(v), false, false); return fmaxf(__uint_as_float(r[0]), __uint_as_float(r[1])); }
__device__ __forceinline__ void mix_sgu(const Frame& F0, const MixArgs& A, int t0) {
    Frame F = F0; F.lane = lane_id_now(); F.tid = F.wave * 64 + F.lane;
    LAS bf16_t* vT = (LAS bf16_t*)F.lds;
    const int w = F.wave, lane = F.lane;
    {
        const int tp = lane & 7, cg = lane >> 3;
        const bf16_t* r0 = A.P + (size_t)(t0 + 16 * w + 2 * tp) * PS + P_GV + 32 * cg;
        float x0[32], x1[32];
#pragma unroll
        for (int c = 0; c < 4; ++c) { const u32x4 a = *((const u32x4*)r0 + c), b = *((const u32x4*)(r0 + PS) + c);
            x0[8 * c + 0] = bf_lo(a.x); x0[8 * c + 1] = bf_hi(a.x); x0[8 * c + 2] = bf_lo(a.y); x0[8 * c + 3] = bf_hi(a.y); x0[8 * c + 4] = bf_lo(a.z); x0[8 * c + 5] = bf_hi(a.z); x0[8 * c + 6] = bf_lo(a.w); x0[8 * c + 7] = bf_hi(a.w);
            x1[8 * c + 0] = bf_lo(b.x); x1[8 * c + 1] = bf_hi(b.x); x1[8 * c + 2] = bf_lo(b.y); x1[8 * c + 3] = bf_hi(b.y); x1[8 * c + 4] = bf_lo(b.z); x1[8 * c + 5] = bf_hi(b.z); x1[8 * c + 6] = bf_lo(b.w); x1[8 * c + 7] = bf_hi(b.w); }
        float s0 = 0.f, s1 = 0.f;
#pragma unroll
        for (int k = 0; k < 32; ++k) { s0 += x0[k]; s1 += x1[k]; }
        s0 += dpp_f<0x128>(s0); s0 += xor16_f(s0); s0 = sum_xor32_f(s0);
        s1 += dpp_f<0x128>(s1); s1 += xor16_f(s1); s1 = sum_xor32_f(s1);
        const float m0 = s0 * (1.0f / 256.0f), m1 = s1 * (1.0f / 256.0f);
        float q0 = 0.f, q1 = 0.f;
#pragma unroll
        for (int k = 0; k < 32; ++k) { x0[k] -= m0; x1[k] -= m1; q0 += x0[k] * x0[k]; q1 += x1[k] * x1[k]; }
        q0 += dpp_f<0x128>(q0); q0 += xor16_f(q0); q0 = sum_xor32_f(q0);
        q1 += dpp_f<0x128>(q1); q1 += xor16_f(q1); q1 = sum_xor32_f(q1);
        const float rs0 = 1.0f / sqrtf(q0 * (1.0f / 256.0f) + EPS), rs1 = 1.0f / sqrtf(q1 * (1.0f / 256.0f) + EPS);
        LAS unsigned* wp = (LAS unsigned*)(vT + (32 * cg) * 136 + 16 * w + 2 * tp);
#pragma unroll
        for (int c = 0; c < 8; ++c) { const f32x4 g = *(const f32x4*)(A.sln_g + 32 * cg + 4 * c), bb = *(const f32x4*)(A.sln_b + 32 * cg + 4 * c);
#pragma unroll
            for (int j = 0; j < 4; ++j) { const int k = 4 * c + j; wp[k * 68] = cvt_pk_bf16(x0[k] * rs0 * g[j] + bb[j], x1[k] * rs1 * g[j] + bb[j]); } }
    }
    __syncthreads();
    const int fr = lane & 15, fq = lane >> 4, t = 16 * w + fr, nks = (w >> 1) + 1;
#pragma unroll 1
    for (int g = 0; g < 4; ++g) {
        f32x4 acc[4];
#pragma unroll
        for (int ct = 0; ct < 4; ++ct) acc[ct] = (f32x4){0.f, 0.f, 0.f, 0.f};
        const bf16_t* wrow = A.sgw + (size_t)(g * 128 + t) * 128 + 8 * fq;
        const LAS bf16_t* vrow = vT + (g * 64 + fr) * 136 + 8 * fq;
#pragma unroll
        for (int ks = 0; ks < 4; ++ks) if (ks < nks) {
            const bf16x8 bw = *(const bf16x8*)(wrow + 32 * ks);
#pragma unroll
            for (int ct = 0; ct < 4; ++ct) { const bf16x8 av = *(const LAS bf16x8*)(vrow + ct * 16 * 136 + 32 * ks); acc[ct] = __builtin_amdgcn_mfma_f32_16x16x32_bf16(av, bw, acc[ct], 0, 0, 0); } }
        const float bias = A.sgu_b[g * 128 + t];
#pragma unroll
        for (int ct = 0; ct < 4; ++ct) { const int c = g * 64 + 16 * ct + 4 * fq;
            const u32x2 uw = *(const u32x2*)(A.P + (size_t)(t0 + t) * PS + P_U + c);
            u32x2 o; o.x = cvt_pk_bf16(bf_lo(uw.x) * (acc[ct][0] + bias), bf_hi(uw.x) * (acc[ct][1] + bias)); o.y = cvt_pk_bf16(bf_lo(uw.y) * (acc[ct][2] + bias), bf_hi(uw.y) * (acc[ct][3] + bias));
            *(u32x2*)(A.ys + (size_t)(t0 + t) * 1024 + c) = o; }
    }
    __syncthreads();
}
__device__ __forceinline__ void mix_attn(const Frame& F0, const MixArgs& A, int t0, bool first) {
    Frame F = F0; F.lane = lane_id_now(); F.tid = F.wave * 64 + F.lane;
    LAS bf16_t* Ks = (LAS bf16_t*)F.lds;
    LAS bf16_t* Vt = (LAS bf16_t*)(F.lds + 36864);
    const int w = F.wave, lane = F.lane, l31 = lane & 31, h = lane >> 5;
#pragma unroll 1
    for (int hk = 0; hk < 2; ++hk) {
        __syncthreads();
        for (int idx = F.tid; idx < 2048; idx += NTHREADS) { const int j = idx >> 3, ch = idx & 7;
            u32x4 v = (u32x4){0u, 0u, 0u, 0u};
            if (!(first && j < 128)) v = *(const u32x4*)(A.P + (size_t)(t0 - 128 + j) * PS + P_K + hk * 64 + ch * 8);
            *(LAS u32x4*)(Ks + j * 72 + ch * 8) = v; }
        for (int it = F.tid; it < 1024; it += NTHREADS) { const int kp = it & 127, dg = it >> 7;
            u32x4 v0 = (u32x4){0u, 0u, 0u, 0u}, v1 = v0;
            if (!(first && kp < 64)) { const bf16_t* src = A.P + (size_t)(t0 - 128 + 2 * kp) * PS + P_V + hk * 64 + dg * 8; v0 = *(const u32x4*)src; v1 = *(const u32x4*)(src + PS); }
            LAS unsigned* dst = (LAS unsigned*)(Vt + (8 * dg) * 260 + 2 * kp);
            dst[0 * 130] = (v0.x & 0xffffu) | (v1.x << 16); dst[1 * 130] = (v0.x >> 16) | (v1.x & 0xffff0000u);
            dst[2 * 130] = (v0.y & 0xffffu) | (v1.y << 16); dst[3 * 130] = (v0.y >> 16) | (v1.y & 0xffff0000u);
            dst[4 * 130] = (v0.z & 0xffffu) | (v1.z << 16); dst[5 * 130] = (v0.z >> 16) | (v1.z & 0xffff0000u);
            dst[6 * 130] = (v0.w & 0xffffu) | (v1.w << 16); dst[7 * 130] = (v0.w >> 16) | (v1.w & 0xffff0000u); }
        __syncthreads();
        const int head = 2 * hk + (w >> 2), qb = w & 3, qi = 32 * qb + l31;
        bf16x8 bq[4];
        { const bf16_t* qp = A.P + (size_t)(t0 + qi) * PS + P_Q + head * 64 + 8 * h;
#pragma unroll
          for (int ks = 0; ks < 4; ++ks) bq[ks] = *(const bf16x8*)(qp + 16 * ks); }
        f32x16 sc[5];
#pragma unroll
        for (int it = 0; it < 5; ++it) {
#pragma unroll
            for (int r = 0; r < 16; ++r) sc[it][r] = 0.f;
            const LAS bf16_t* kp = Ks + (32 * (qb + it) + l31) * 72 + 8 * h;
#pragma unroll
            for (int ks = 0; ks < 4; ++ks) sc[it] = __builtin_amdgcn_mfma_f32_32x32x16_bf16(*(const LAS bf16x8*)(kp + 16 * ks), bq[ks], sc[it], 0, 0, 0); }
        const float sink = A.sinks[head];
        float mx = sink;
        int qiv = qi; asm volatile("" : "+v"(qiv));
#pragma unroll
        for (int it = 0; it < 5; ++it) {
            const bool dead = first && (qb + it) < 4;
#pragma unroll
            for (int r = 0; r < 16; ++r) { const int kb = 32 * (qb + it) + (r & 3) + 8 * (r >> 2) + 4 * h;
                bool valid = !dead;
                if (it == 0) valid = valid && (kb > qiv);
                if (it == 4) valid = valid && (kb <= qiv + 128);
                const float v = valid ? sc[it][r] : -INFINITY; sc[it][r] = v; mx = fmaxf(mx, v); } }
        mx = max_xor32_f(mx);
        float l = 0.f;
#pragma unroll
        for (int it = 0; it < 5; ++it)
#pragma unroll
            for (int r = 0; r < 16; ++r) { const float p = __builtin_amdgcn_exp2f((sc[it][r] - mx) * 1.44269504089f); sc[it][r] = p; l += p; }
        l = sum_xor32_f(l) + __builtin_amdgcn_exp2f((sink - mx) * 1.44269504089f);
        f32x16 o[2];
#pragma unroll
        for (int dt = 0; dt < 2; ++dt)
#pragma unroll
            for (int r = 0; r < 16; ++r) o[dt][r] = 0.f;
#pragma unroll
        for (int it = 0; it < 5; ++it)
#pragma unroll
            for (int st = 0; st < 2; ++st) {
                union { u32x4 u; bf16x8 v; } pb;
                pb.u.x = cvt_pk_bf16(sc[it][8 * st + 0], sc[it][8 * st + 1]); pb.u.y = cvt_pk_bf16(sc[it][8 * st + 2], sc[it][8 * st + 3]);
                pb.u.z = cvt_pk_bf16(sc[it][8 * st + 4], sc[it][8 * st + 5]); pb.u.w = cvt_pk_bf16(sc[it][8 * st + 6], sc[it][8 * st + 7]);
#pragma unroll
                for (int dt = 0; dt < 2; ++dt) { const LAS bf16_t* vp = Vt + (32 * dt + l31) * 260 + 32 * (qb + it) + 16 * st + 4 * h;
                    union { u32x4 u; bf16x8 v; } va; const u32x2 lo = *(const LAS u32x2*)vp, hi = *(const LAS u32x2*)(vp + 8);
                    va.u = (u32x4){lo.x, lo.y, hi.x, hi.y};
                    o[dt] = __builtin_amdgcn_mfma_f32_32x32x16_bf16(va.v, pb.v, o[dt], 0, 0, 0); } }
        const float il = 1.0f / l;
        bf16_t* op = A.ys + (size_t)(t0 + qi) * 1024 + 256 + head * 64 + 4 * h;
#pragma unroll
        for (int dt = 0; dt < 2; ++dt)
#pragma unroll
            for (int g4 = 0; g4 < 4; ++g4) { u32x2 ov; ov.x = cvt_pk_bf16(o[dt][4 * g4] * il, o[dt][4 * g4 + 1] * il); ov.y = cvt_pk_bf16(o[dt][4 * g4 + 2] * il, o[dt][4 * g4 + 3] * il);
                *(u32x2*)(op + 32 * dt + 8 * g4) = ov; }
    }
    __syncthreads();
}
__device__ __forceinline__ void mix_conv3(const Frame& F0, const MixArgs& A, int t0, bool first) {
    Frame F = F0; F.lane = lane_id_now(); F.tid = F.wave * 64 + F.lane;
    const int c8 = (F.tid & 31) * 8, tq = (F.tid >> 5) * 8;
    f32x4 w[3][2];
#pragma unroll
    for (int j = 0; j < 3; ++j) { w[j][0] = *(const f32x4*)(A.c3w + j * 256 + c8); w[j][1] = *(const f32x4*)(A.c3w + j * 256 + c8 + 4); }
    f32x4 x[10][2];
#pragma unroll
    for (int r = 0; r < 10; ++r) { const int t = tq - 2 + r;
        if (t < 0 && first) { x[r][0] = (f32x4){0.f, 0.f, 0.f, 0.f}; x[r][1] = x[r][0]; }
        else unpack8(*(const u32x4*)(A.P + (size_t)(t0 + t) * PS + P_BX + c8), x[r][0], x[r][1]); }
#pragma unroll
    for (int i = 0; i < 8; ++i) { f32x4 cc0, cc1; unpack8(*(const u32x4*)(A.P + (size_t)(t0 + tq + i) * PS + P_CC + c8), cc0, cc1);
        const f32x4 y0 = w[0][0] * x[i][0] + w[1][0] * x[i + 1][0] + w[2][0] * x[i + 2][0], y1 = w[0][1] * x[i][1] + w[1][1] * x[i + 1][1] + w[2][1] * x[i + 2][1];
        *(u32x4*)(A.ys + (size_t)(t0 + tq + i) * 1024 + 512 + c8) = pack8(cc0 * y0, cc1 * y1); }
}
__device__ __forceinline__ void mix_conv31(const Frame& F0, const MixArgs& A, int t0, bool first) {
    Frame F = F0; F.lane = lane_id_now(); F.tid = F.wave * 64 + F.lane;
    LAS bf16_t* gl = (LAS bf16_t*)F.lds;
    for (int idx = F.tid; idx < 158 * 32; idx += NTHREADS) { const int r = idx >> 5, ch = idx & 31;
        u32x4 w = (u32x4){0u, 0u, 0u, 0u};
        if (!(first && r < 30)) w = *(const u32x4*)(A.P + (size_t)(t0 - 30 + r) * PS + P_GLU + ch * 8);
        *(LAS u32x4*)(gl + r * 256 + ch * 8) = w; }
    __syncthreads();
    const int c4 = F.lane * 4, tr = F.wave * 16;
    const f32x4 bias = *(const f32x4*)(A.c31b + c4);
    f32x4 acc[16];
#pragma unroll
    for (int i = 0; i < 16; ++i) acc[i] = bias;
#pragma unroll 1
    for (int j = 0; j < 31; ++j) { const f32x4 w = *(const f32x4*)(A.c31w + j * 256 + c4);
        const LAS bf16_t* xp = gl + (tr + j) * 256 + c4;
#pragma unroll
        for (int i = 0; i < 16; ++i) { const u32x2 p = *(const LAS u32x2*)(xp + i * 256); acc[i] += w * (f32x4){bf_lo(p.x), bf_hi(p.x), bf_lo(p.y), bf_hi(p.y)}; } }
    const f32x4 g = *(const f32x4*)(A.cn_g + c4), b = *(const f32x4*)(A.cn_b + c4);
#pragma unroll
    for (int i = 0; i < 16; ++i) {
        f32x4 v = acc[i];
        const float mean = wave_sum((v[0] + v[1]) + (v[2] + v[3])) * (1.0f / 256.0f);
        v = v - mean;
        const float var = wave_sum((v[0] * v[0] + v[1] * v[1]) + (v[2] * v[2] + v[3] * v[3])) * (1.0f / 256.0f);
        const float rstd = 1.0f / sqrtf(var + EPS);
        v = v * rstd * g + b;
        u32x2 o; o.x = cvt_pk_bf16(silu_f(v[0]), silu_f(v[1])); o.y = cvt_pk_bf16(silu_f(v[2]), silu_f(v[3]));
        *(u32x2*)(A.ys + (size_t)(t0 + tr + i) * 1024 + 768 + c4) = o; }
    __syncthreads();
}
__device__ __forceinline__ void mixer_phase(const Frame& F0, const MixArgs& A) {
    Frame F = F0; F.lane = lane_id_now(); F.tid = F.wave * 64 + F.lane; asm volatile("" : "+s"(F.G), "+s"(F.vcu));
    for (int ch = F.vcu; ch < NTOK / 128; ch += F.G) {
        const int t0 = ch * 128; const bool first = (ch % (SEQ / 128)) == 0;
        #ifndef MIX_MASK
#define MIX_MASK 15
#endif
        if (MIX_MASK & 1) mix_sgu(F, A, t0); if (MIX_MASK & 2) mix_attn(F, A, t0, first); if (MIX_MASK & 4) mix_conv3(F, A, t0, first); if (MIX_MASK & 8) mix_conv31(F, A, t0, first);
        if (ABL & 15) { __syncthreads(); for (int idx = F.tid; idx < 128 * 128; idx += NTHREADS) { const int r = idx >> 7, c8 = (idx & 127) * 8, br = c8 >> 8;
            if ((ABL >> br) & 1) *(u32x4*)(A.ys + (size_t)(t0 + r) * 1024 + c8) = (u32x4){0u, 0u, 0u, 0u}; } }
    }
}

struct RouteArgs { const float* x1; const float* g2; const float *wgrp, *bgrp, *wexp, *bexp; float* rs; int* bkt; float *wlo, *whi; int* slot_tok; unsigned* blk_hist; bf16_t* xb; };
__device__ __forceinline__ void router_phase(const Frame& F0, const RouteArgs& R) {
    Frame F = F0; F.lane = lane_id_now(); F.tid = F.wave * 64 + F.lane; asm volatile("" : "+s"(F.G), "+s"(F.vcu));
    constexpr int WS = 1032;
    LAS bf16_t* Wh = (LAS bf16_t*)F.lds; LAS bf16_t* Wl = Wh + 20 * WS;
    LAS float* lg = (LAS float*)(F.lds + 20 * WS * 4) + F.wave * 512;
    LAS unsigned* hist = (LAS unsigned*)(F.lds + 20 * WS * 4 + 8 * 2048);
    for (int idx = F.tid; idx < 1024 * 20; idx += NTHREADS) { const int k = idx / 20, n = idx - 20 * k;
        const float v = R.g2[k] * (n < 4 ? R.wgrp[k * 4 + n] : R.wexp[k * 16 + n - 4]);
        const unsigned hi = cvt_pk_bf16(v, 0.f) & 0xffffu; const unsigned lo = cvt_pk_bf16(v - bf_lo(hi), 0.f) & 0xffffu;
        Wh[n * WS + k] = (bf16_t)hi; Wl[n * WS + k] = (bf16_t)lo; }
    if (F.tid < 32) hist[F.tid] = 0u;
    { const int gt = F.vcu * NTHREADS + F.tid, NGT = F.G * NTHREADS; for (int idx = gt; idx < MPAD_MAX; idx += NGT) R.slot_tok[idx] = -1; }
    __syncthreads();
    const int fr = F.lane & 15, fq = F.lane >> 4;
    const int n1 = (16 + fr) < 20 ? (16 + fr) : fr;
    const LAS bf16_t* bh0 = Wh + fr * WS + 8 * fq; const LAS bf16_t* bl0 = Wl + fr * WS + 8 * fq;
    const LAS bf16_t* bh1 = Wh + n1 * WS + 8 * fq; const LAS bf16_t* bl1 = Wl + n1 * WS + 8 * fq;
    for (int tb = F.vcu; tb < NTOK / 128; tb += F.G) {
        const int tok = tb * 128 + F.wave * 16 + fr;
        const float* xr = R.x1 + (size_t)tok * D + 8 * fq;
        bf16_t* xo = R.xb + (size_t)tok * D + 8 * fq;
        f32x4 acc0 = (f32x4){0.f, 0.f, 0.f, 0.f}, acc1 = acc0; float ss = 0.f;
#pragma unroll 1
        for (int k8 = 0; k8 < 4; ++k8) {
            f32x4 xa[8], xc[8];
#pragma unroll
            for (int q = 0; q < 8; ++q) { xa[q] = *(const f32x4*)(xr + (k8 * 8 + q) * 32); xc[q] = *(const f32x4*)(xr + (k8 * 8 + q) * 32 + 4); }
#pragma unroll
            for (int q = 0; q < 8; ++q) { const int ks = k8 * 8 + q; const f32x4 a = xa[q], c = xc[q];
                ss += (a[0] * a[0] + a[1] * a[1]) + (a[2] * a[2] + a[3] * a[3]) + (c[0] * c[0] + c[1] * c[1]) + (c[2] * c[2] + c[3] * c[3]);
                union { u32x4 u; bf16x8 v; } hi, lo;
                hi.u.x = cvt_pk_bf16(a[0], a[1]); hi.u.y = cvt_pk_bf16(a[2], a[3]); hi.u.z = cvt_pk_bf16(c[0], c[1]); hi.u.w = cvt_pk_bf16(c[2], c[3]);
                lo.u.x = cvt_pk_bf16(a[0] - bf_lo(hi.u.x), a[1] - bf_hi(hi.u.x)); lo.u.y = cvt_pk_bf16(a[2] - bf_lo(hi.u.y), a[3] - bf_hi(hi.u.y));
                lo.u.z = cvt_pk_bf16(c[0] - bf_lo(hi.u.z), c[1] - bf_hi(hi.u.z)); lo.u.w = cvt_pk_bf16(c[2] - bf_lo(hi.u.w), c[3] - bf_hi(hi.u.w));
                *(u32x4*)(xo + ks * 32) = hi.u;
                const bf16x8 wh0 = *(const LAS bf16x8*)(bh0 + ks * 32), wl0 = *(const LAS bf16x8*)(bl0 + ks * 32), wh1 = *(const LAS bf16x8*)(bh1 + ks * 32), wl1 = *(const LAS bf16x8*)(bl1 + ks * 32);
                acc0 = __builtin_amdgcn_mfma_f32_16x16x32_bf16(hi.v, wh0, acc0, 0, 0, 0); acc0 = __builtin_amdgcn_mfma_f32_16x16x32_bf16(hi.v, wl0, acc0, 0, 0, 0); acc0 = __builtin_amdgcn_mfma_f32_16x16x32_bf16(lo.v, wh0, acc0, 0, 0, 0);
                acc1 = __builtin_amdgcn_mfma_f32_16x16x32_bf16(hi.v, wh1, acc1, 0, 0, 0); acc1 = __builtin_amdgcn_mfma_f32_16x16x32_bf16(hi.v, wl1, acc1, 0, 0, 0); acc1 = __builtin_amdgcn_mfma_f32_16x16x32_bf16(lo.v, wh1, acc1, 0, 0, 0); }
        }
        ss += xor16_f(ss); ss = sum_xor32_f(ss);
        const float rs = 1.0f / sqrtf(ss * (1.0f / D) + EPS);
#pragma unroll
        for (int r = 0; r < 4; ++r) { lg[(4 * fq + r) * 32 + fr] = acc0[r]; lg[(4 * fq + r) * 32 + 16 + fr] = acc1[r]; }
        LDS_WAIT(); asm volatile("" ::: "memory");
        if (F.lane < 16) {
            const LAS float* lp = lg + fr * 32;
            float gl[4]; int gi = 0;
#pragma unroll
            for (int k = 0; k < 4; ++k) gl[k] = lp[k] * rs + R.bgrp[k];
            float gm = gl[0];
#pragma unroll
            for (int k = 1; k < 4; ++k) if (gl[k] > gm) { gm = gl[k]; gi = k; }
            float den = 0.f;
#pragma unroll
            for (int k = 0; k < 4; ++k) den += expf(gl[k] - gm);
            const float gwt = 1.0f / den;
            float el[4];
#pragma unroll
            for (int k = 0; k < 4; ++k) el[k] = lp[4 + gi * 4 + k] * rs + R.bexp[gi * 4 + k];
            int i1 = 0; float v1 = el[0];
#pragma unroll
            for (int k = 1; k < 4; ++k) if (el[k] > v1) { v1 = el[k]; i1 = k; }
            int i2 = -1; float v2 = 0.f;
#pragma unroll
            for (int k = 0; k < 4; ++k) if (k != i1 && (i2 < 0 || el[k] > v2)) { v2 = el[k]; i2 = k; }
            const float e2 = expf(v2 - v1), tw1 = gwt / (1.0f + e2), tw2 = gwt * e2 / (1.0f + e2);
            const int lo_ = i1 < i2 ? i1 : i2, hi_ = i1 < i2 ? i2 : i1;
            const int pr = lo_ == 0 ? hi_ - 1 : (lo_ == 1 ? hi_ + 1 : 5);
            const int bucket = gi * 6 + pr;
            R.rs[tok] = rs; R.bkt[tok] = bucket; R.wlo[tok] = i1 < i2 ? tw1 : tw2; R.whi[tok] = i1 < i2 ? tw2 : tw1;
            __hip_atomic_fetch_add(&hist[bucket], 1u, __ATOMIC_RELAXED, __HIP_MEMORY_SCOPE_WORKGROUP);
        }
        LDS_WAIT(); asm volatile("" ::: "memory");
        __syncthreads();
        if (F.tid < 32) { R.blk_hist[tb * 32 + F.tid] = hist[F.tid]; hist[F.tid] = 0u; }
        __syncthreads();
    }
}
struct SlotArgs { const bf16_t* xb; const float* rs; const int* bkt; const float *wlo, *whi; int* slot_tok; float* slot_w; bf16_t* h2s; const unsigned* blk_hist; unsigned* ntiles; unsigned* tile_bucket; };
__device__ __forceinline__ void slot_phase(const Frame& F0, const SlotArgs& S) {
    Frame F = F0; F.lane = lane_id_now(); F.tid = F.wave * 64 + F.lane; asm volatile("" : "+s"(F.G), "+s"(F.vcu));
    LAS int* offs = (LAS int*)F.lds;
    LAS unsigned* lcnt = (LAS unsigned*)(F.lds + 128);
    LAS unsigned* base = (LAS unsigned*)(F.lds + 256);
    LAS unsigned* part = (LAS unsigned*)(F.lds + 512);
    if (F.tid < 16 * NBUCKET) { const int b = F.tid % NBUCKET, seg = F.tid / NBUCKET; unsigned a = 0;
#pragma unroll
        for (int i = 0; i < 16; ++i) a += S.blk_hist[(seg * 16 + i) * 32 + b];
        part[seg * NBUCKET + b] = a; }
    __syncthreads();
    if (F.tid == 0) { int off = 0; for (int b = 0; b < NBUCKET; ++b) { int c = 0; for (int sg = 0; sg < 16; ++sg) c += (int)part[sg * NBUCKET + b]; offs[b] = off; off += (c + 255) & ~255; } offs[NBUCKET] = off; }
    __syncthreads();
    const int nT = offs[NBUCKET] >> 8;
    if (blockIdx.x == 0) {
        if (F.tid == 0) __hip_atomic_store(S.ntiles, (unsigned)nT, __ATOMIC_RELAXED, __HIP_MEMORY_SCOPE_AGENT);
        if (F.tid < nT) { int tb = 0; for (int b = 0; b < NBUCKET; ++b) if (F.tid * 256 >= offs[b] && F.tid * 256 < offs[b + 1]) tb = b;
            __hip_atomic_store(S.tile_bucket + F.tid, (unsigned)tb, __ATOMIC_RELAXED, __HIP_MEMORY_SCOPE_AGENT); }
    }
    for (int tb = F.vcu; tb < NTOK / 128; tb += F.G) {
        if (F.tid < NBUCKET) { lcnt[F.tid] = 0u; unsigned a = 0; const int sg = tb >> 4;
            for (int q = 0; q < sg; ++q) a += part[q * NBUCKET + F.tid];
            for (int i = 0; i < (tb & 15); ++i) a += S.blk_hist[(sg * 16 + i) * 32 + F.tid];
            base[F.tid] = a; }
        __syncthreads();
        const int tokl = tb * 128 + F.wave * 16 + (F.lane & 15);
        int bk = 0; unsigned rank = 0;
        if (F.lane < 16) { bk = S.bkt[tokl]; rank = __hip_atomic_fetch_add(&lcnt[bk], 1u, __ATOMIC_RELAXED, __HIP_MEMORY_SCOPE_WORKGROUP); }
        int slot = 0;
        if (F.lane < 16) { slot = offs[bk] + (int)base[bk] + (int)rank; S.slot_tok[slot] = tokl; *(f32x4*)(S.slot_w + slot * 4) = (f32x4){S.wlo[tokl], S.whi[tokl], S.rs[tokl], 0.f}; }
        const u32x4* src = (const u32x4*)(S.xb + (size_t)(tb * 128 + F.wave * 16) * D) + F.lane;
        u32x4 ra[16], rb[16];
#pragma unroll
        for (int i = 0; i < 16; ++i) { ra[i] = src[i * 128]; rb[i] = src[i * 128 + 64]; }
#pragma unroll
        for (int i = 0; i < 16; ++i) { const int si = __builtin_amdgcn_readlane(slot, i); u32x4* dst = (u32x4*)(S.h2s + (size_t)si * D) + F.lane; dst[0] = ra[i]; dst[64] = rb[i]; }
        __syncthreads();
    }
}

constexpr int N_PHASES = 1 + 10 * DEPTH;
#ifndef PH_MASK
#define PH_MASK 0x7ff
#endif
#define PHON(k) (((PH_MASK) >> (k)) & 1)
__global__ void __launch_bounds__(NTHREADS, 2) fwd(Args args) {
    extern __shared__ __attribute__((aligned(16))) unsigned char lds[];
    Frame F;
    F.lds = (LAS unsigned char*)lds; F.ws = args.ws; F.ctl = (unsigned*)(args.ws + WS_CTL);
    F.wave = __builtin_amdgcn_readfirstlane((int)threadIdx.x >> 6); F.lane = 0; F.tid = 0;
    F.G = gridDim.x; { const int bx = blockIdx.x; F.vcu = (F.G % 8 == 0) ? (bx % 8) * (F.G / 8) + bx / 8 : bx; }
    volatile LAS unsigned* lctl = (volatile LAS unsigned*)(F.lds + LDSCTL_OFF);
    if (threadIdx.x < 64) lctl[threadIdx.x] = 0u;
    __syncthreads();
    const int lo = args.ph_lo, hi = args.ph_hi;
    XcdBarrier bar; bar.bar = F.ctl + CW_BAR; bar.x = 0; bar.st = lctl; bar.wave = F.wave;
    if (hi - lo > 1) bar = xcd_barrier_post(F.ctl + CW_BAR, lctl);
#define IN(k) (lo <= (k) && (k) < hi)
#define SEAM(k) do { if (IN(k) && IN((k) + 1)) xcd_barrier(bar); } while (0)
    unsigned char* ws = args.ws;
    const float* x0 = (const float*)args.in[I_X];
    bf16_t* Hb = (bf16_t*)(ws + WS_HM); bf16_t* Pb = (bf16_t*)(ws + WS_BIG); bf16_t* Gb = (bf16_t*)(ws + WS_BIG); bf16_t* Mg = (bf16_t*)(ws + BIG_MG);
    bf16_t* Ys = (bf16_t*)(ws + WS_YS); float* X1 = (float*)(ws + BIG_X1); bf16_t* H2s = (bf16_t*)(ws + BIG_H2S); bf16_t* Hid = (bf16_t*)(ws + BIG_HID);
    float* aux_rs = (float*)(ws + AUX_RS); int* aux_bkt = (int*)(ws + AUX_BKT); float* aux_wlo = (float*)(ws + AUX_WLO); float* aux_whi = (float*)(ws + AUX_WHI);
    int* slot_tok = (int*)(ws + AUX_STOK); float* slot_w = (float*)(ws + AUX_SW); unsigned* tile_bucket = (unsigned*)(ws + AUX_TB); unsigned* blk_hist = (unsigned*)(ws + AUX_BH);

    if (PHON(0) && IN(0)) { p0_weights(F, args); norm_rows(F, x0, (const float*)args.in[I_N1G], Hb); }
    SEAM(0);
    for (int l = 0; l < DEPTH; ++l) {
        const int pb = 1 + 10 * l;
        const float* xin = (l == 0) ? x0 : (const float*)args.out;
        unsigned char* wl = ws + WS_W + (size_t)l * W_LAYER;
        unsigned* ntiles = F.ctl + CW_CNT + 64 * l + 60;
        if (PHON(1) && IN(pb + 0) && l > 0) norm_rows(F, xin, (const float*)args.in[I_N1G] + (size_t)l * D, Hb);
        if (l > 0) SEAM(pb + 0);
        if (PHON(2) && IN(pb + 1)) {
            PlainOrder S{(const char*)Hb, (const char*)(wl + W_IN), 128, 9, F.G, (int)blockIdx.x, (size_t)256 * D * 2, (size_t)256 * D * 2};
            EpiInProj E{Pb, (const float*)(ws + WS_ROPE), (const float*)args.in[I_QNG] + l * 64, (const float*)args.in[I_KNG] + l * 64};
            pg8::gemm_phase<EpiInProj, PlainOrder>(F.lds, F.wave, D, D, D, S, E);
        }
        SEAM(pb + 1);
        if (PHON(3) && IN(pb + 2)) {
            MixArgs A{Pb, Ys, (const bf16_t*)(ws + WS_SGU) + (size_t)l * 4 * 128 * 128, (const float*)args.in[I_SLNG] + l * 256, (const float*)args.in[I_SLNB] + l * 256, (const float*)args.in[I_SGUW] + (size_t)l * 4 * 128 * 128, (const float*)args.in[I_SGUB] + l * 4 * 128,
                      (const float*)args.in[I_SINK] + l * 4, (const float*)args.in[I_C3W] + l * 3 * 256, (const float*)args.in[I_C31W] + l * 31 * 256, (const float*)args.in[I_C31B] + l * 256,
                      (const float*)args.in[I_CNG] + l * 256, (const float*)args.in[I_CNB] + l * 256};
            mixer_phase(F, A);
        }
        SEAM(pb + 2);
        if (PHON(4) && IN(pb + 3)) {
            GateMergeOrder S{(const char*)Hb, (const char*)Ys, (const char*)(wl + W_GATE), (const char*)(wl + W_BR), F.G, (int)blockIdx.x};
            EpiGateMerge E{(bf16_t*)(ws + BIG_GS) + (size_t)blockIdx.x * 65536, (bf16_t*)(ws + BIG_MS) + (size_t)blockIdx.x * 65536, Mg, (const float*)args.in[I_BGATE] + (size_t)l * 4096};
            for (int r_ = 0; r_ < 1; ++r_) pg8::gemm_phase<EpiGateMerge, GateMergeOrder>(F.lds, F.wave, D, D, D, S, E);
        }
        SEAM(pb + 3);
        if (PHON(6) && IN(pb + 5)) {
            PlainOrder S{(const char*)Mg, (const char*)(wl + W_O), 128, 4, F.G, (int)blockIdx.x, (size_t)256 * D * 2, (size_t)256 * D * 2};
            EpiWo E{xin, X1};
            pg8::gemm_phase<EpiWo, PlainOrder>(F.lds, F.wave, D, D, D, S, E);
        }
        SEAM(pb + 5);
        if (PHON(7) && IN(pb + 6)) {
            RouteArgs R{X1, (const float*)args.in[I_N2G] + (size_t)l * D, (const float*)args.in[I_WGRP] + (size_t)l * D * 4, (const float*)args.in[I_BGRP] + l * 4,
                        (const float*)args.in[I_WEXP] + (size_t)l * D * 16, (const float*)args.in[I_BEXP] + l * 16, aux_rs, aux_bkt, aux_wlo, aux_whi, slot_tok, blk_hist, Hb};
            router_phase(F, R);
        }
        SEAM(pb + 6);
        if (PHON(8) && IN(pb + 7)) {
            SlotArgs S{Hb, aux_rs, aux_bkt, aux_wlo, aux_whi, slot_tok, slot_w, H2s, blk_hist, ntiles, tile_bucket};
            slot_phase(F, S);
        }
        SEAM(pb + 7);
        if (PHON(9) && IN(pb + 8)) {
            const int nT = __builtin_amdgcn_readfirstlane((int)xb_ld(ntiles));
            MoeUpOrder S{(const char*)H2s, (const char*)(wl + W_GU), tile_bucket, nT, F.G, F.vcu};
            EpiMoeUp E{Hid, slot_w};
            pg8::gemm_phase<EpiMoeUp, MoeUpOrder>(F.lds, F.wave, D, D, D, S, E);
        }
        SEAM(pb + 8);
        if (PHON(10) && IN(pb + 9)) {
            const int nT = __builtin_amdgcn_readfirstlane((int)xb_ld(ntiles));
            MoeDownOrder S{(const char*)Hid, (const char*)(wl + W_DN), tile_bucket, nT, F.G, F.vcu};
            EpiMoeDown E{slot_tok, X1, args.out};
            pg8::gemm_phase<EpiMoeDown, MoeDownOrder>(F.lds, F.wave, 512, 512, 256, S, E);
        }
        if (l + 1 < DEPTH) SEAM(pb + 9);
    }
#undef IN
#undef SEAM
}

extern "C" void kernel_launch(void* const* d_in, const int* in_sizes, int n_in, void* d_out, int out_size, void* d_ws, size_t ws_size, hipStream_t stream) {
    static int grid = 0;
    if (grid == 0) {
        if (n_in != N_IN || out_size != NTOK * D || ws_size < WS_END) { fprintf(stderr, "kernel_launch: unexpected shapes (n_in %d, out %d, ws %zu); nothing launched\n", n_in, out_size, ws_size); grid = -1; return; }
        int dev = 0, cus = 0, per_cu = 0;
        if (hipGetDevice(&dev) != hipSuccess || hipDeviceGetAttribute(&cus, hipDeviceAttributeMultiprocessorCount, dev) != hipSuccess) { grid = -1; return; }
        if (hipFuncSetAttribute((const void*)fwd, hipFuncAttributeMaxDynamicSharedMemorySize, LDS_BYTES) != hipSuccess) { fprintf(stderr, "kernel_launch: hipFuncSetAttribute failed\n"); grid = -1; return; }
        if (hipOccupancyMaxActiveBlocksPerMultiprocessor(&per_cu, (const void*)fwd, NTHREADS, LDS_BYTES) != hipSuccess || per_cu < 1)
            fprintf(stderr, "kernel_launch: note: occupancy query reports %d workgroups per CU\n", per_cu);
        (void)hipGetLastError();
        grid = cus;
    }
    if (grid < 0) return;
    (void)hipMemsetAsync((char*)d_ws + WS_CTL, 0, CTL_ZERO_BYTES, stream);
    Args a{};
    for (int i = 0; i < N_IN; ++i) a.in[i] = d_in[i];
    a.out = (float*)d_out; a.ws = (unsigned char*)d_ws;
#if MK_PER_PHASE
    for (int p = 0; p < N_PHASES; ++p) { if (p == 1) continue; a.ph_lo = p; a.ph_hi = p + 1; hipLaunchKernelGGL(fwd, dim3(grid), dim3(NTHREADS), LDS_BYTES, stream, a); }
#else
    a.ph_lo = 0; a.ph_hi = N_PHASES;
    hipLaunchKernelGGL(fwd, dim3(grid), dim3(NTHREADS), LDS_BYTES, stream, a);
#endif
}
```

```cpp
#include <hip/hip_runtime.h>
#include <cstdio>
#include <cstdint>

#ifndef ABL
#define ABL 0
#endif
#ifndef MK_PER_PHASE
#define MK_PER_PHASE 0
#endif

#define LAS __attribute__((address_space(3)))
#define GAS __attribute__((address_space(1)))
typedef unsigned short bf16_t;
typedef short bf16x8 __attribute__((ext_vector_type(8)));
typedef float f32x4 __attribute__((ext_vector_type(4)));
typedef float f32x2 __attribute__((ext_vector_type(2)));
typedef unsigned u32x4 __attribute__((ext_vector_type(4)));
typedef unsigned u32x2 __attribute__((ext_vector_type(2)));

constexpr int NB = 8, SEQ = 4096, D = 1024, NTOK = NB * SEQ, DEPTH = 2;
constexpr int DIN = 2304, PS = 1792;
constexpr int P_U = 0, P_GV = 256, P_Q = 512, P_K = 768, P_V = 896, P_BX = 1024, P_CC = 1280, P_GLU = 1536;
constexpr int NEXP = 16, DEXP = 256, NBUCKET = 24;
constexpr int MPAD_MAX = NTOK + NBUCKET * 256;
constexpr float EPS = 1e-6f;

typedef __bf16 bf16x2_t __attribute__((ext_vector_type(2)));
__device__ __forceinline__ unsigned cvt_pk_bf16(float lo, float hi) { const bf16x2_t v = {(__bf16)lo, (__bf16)hi}; return __builtin_bit_cast(unsigned, v); }
__device__ __forceinline__ float bf_lo(unsigned w) { return __uint_as_float(w << 16); }
__device__ __forceinline__ float bf_hi(unsigned w) { return __uint_as_float(w & 0xffff0000u); }
__device__ __forceinline__ float bf2f(bf16_t h) { return __uint_as_float(((unsigned)h) << 16); }
__device__ __forceinline__ float sigmoid_f(float x) { return __builtin_amdgcn_rcpf(1.0f + __builtin_amdgcn_exp2f(-1.44269504089f * x)); }
__device__ __forceinline__ float gelu_tanh_f(float x) {
    const float t = x * (1.0f + 0.044715f * x * x); return x * sigmoid_f(1.5957691216f * t); }
__device__ __forceinline__ float silu_f(float x) { return x * sigmoid_f(x); }

__device__ __forceinline__ int lane_id_now() { int l; asm volatile("v_mbcnt_lo_u32_b32 %0, -1, 0\n\tv_mbcnt_hi_u32_b32 %0, -1, %0" : "=v"(l)); return l; }
template <int CTRL> __device__ __forceinline__ float dpp_f(float v) { return __int_as_float(__builtin_amdgcn_mov_dpp(__float_as_int(v), CTRL, 0xf, 0xf, true)); }
__device__ __forceinline__ float xor16_f(float v) { return __int_as_float(__builtin_amdgcn_ds_swizzle(__float_as_int(v), 0x401F)); }
__device__ __forceinline__ float sum_xor32_f(float v) { const auto r = __builtin_amdgcn_permlane32_swap(__float_as_uint(v), __float_as_uint(v), false, false); return __uint_as_float(r[0]) + __uint_as_float(r[1]); }
__device__ __forceinline__ float wave_sum(float v) {
    v += dpp_f<0xB1>(v); v += dpp_f<0x4E>(v); v += dpp_f<0x141>(v); v += dpp_f<0x140>(v);
    v += xor16_f(v); return sum_xor32_f(v);
}

namespace pg8 {
constexpr int BM = 256, BK = 64, HALF = 128, HTB = HALF * BK * 2  , STAGE_BYTES = 8 * HTB, NXCD = 8, WGM = 8;
__host__ __device__ __forceinline__ int lds_byte(int r, int c) { const int st = (r >> 4) * 2 + (c >> 5), rr = r & 15, cc = c & 31, ob = rr * 64 + cc * 2; return st * 1024 + (ob ^ (((ob >> 9) & 1) << 5)); }
__host__ __device__ __forceinline__ void stage_rc(int b, int& R, int& C) { const int st = b / 1024, sb = b % 1024, swz = sb ^ (((sb >> 9) & 1) << 5); R = (st >> 1) * 16 + swz / 64; C = (st & 1) * 32 + (swz % 64) / 2; }
__host__ __device__ __forceinline__ int perm32(int rho) { const int n = rho >> 4, i = rho & 15; return 8 * (i >> 2) + 4 * n + (i & 3); }

struct Unit { int pm, pn, aux; };

__device__ __forceinline__ void tile_of(int L, int nM, int nN, int& pm, int& pn) {
    const int nwg = nM * nN; int wgid = L; { const int q = nwg / NXCD, r = nwg % NXCD, xcd = wgid % NXCD, off = wgid / NXCD; wgid = (xcd < r ? xcd * (q + 1) : r * (q + 1) + (xcd - r) * q) + off; }
    const int nig = WGM * nN, gid = wgid / nig, fm = gid * WGM, gsz = (nM - fm) < WGM ? (nM - fm) : WGM;
    pm = fm + ((wgid % nig) % gsz); pn = (wgid % nig) / gsz;
}

template <class Epi, class Sched>
__device__ __forceinline__ void gemm_phase(LAS unsigned char* lds, const int wid  , const int K, const int lda, const int ldb, const Sched& S, const Epi& E) {
    const int lane = lane_id_now(), tid = wid * 64 + lane;
    const int wr = wid >> 2, wc = wid & 3, fr = lane & 15, fq = lane >> 4;
    int nt = K / BK; asm volatile("" : "+s"(nt));
    unsigned voffA[2], voffB[2];
#pragma unroll
    for (int i = 0; i < 2; ++i) { int R, C; stage_rc(tid * 16 + i * 8192, R, C); const int Rb = Epi::PERM ? ((R & ~31) + perm32(R & 31)) : R;
        voffA[i] = (unsigned)(R * lda + C) * 2u; voffB[i] = (unsigned)(Rb * ldb + C) * 2u; }
    asm volatile("" : "+v"(voffA[0]), "+v"(voffA[1]), "+v"(voffB[0]), "+v"(voffB[1]));
    const size_t kstep = (size_t)(BK * 2);
    const size_t hstepA = (size_t)HALF * lda * 2, hstepB = (size_t)HALF * ldb * 2;
    const unsigned ldsw = (unsigned)wid * 1024u;
    const int aoff = lds_byte(wr * 64 + fr, fq * 8), boff = lds_byte(wc * 32 + fr, fq * 8);
#define PG8_SA(b, h) (((b) * 2 + (h)) * HTB)
#define PG8_SB(b, h) ((4 + (b) * 2 + (h)) * HTB)
#define PG8_STAGE(bufoff, gbase, voff) do { _Pragma("unroll") for (int _i = 0; _i < 2; ++_i) \
        __builtin_amdgcn_global_load_lds((const unsigned*)((const char*)(gbase) + (voff)[_i]), (LAS unsigned*)(lds + (bufoff) + ldsw + _i * 8192), 16, 0, 0); } while (0)
#define PG8_LDA(dst, b, h) do { _Pragma("unroll") for (int m = 0; m < 4; ++m) _Pragma("unroll") for (int k = 0; k < 2; ++k) dst[m][k] = *(const LAS bf16x8*)(lds + PG8_SA(b, h) + aoff + m * 2048 + k * 1024); } while (0)
#define PG8_LDB(dst, b, h) do { _Pragma("unroll") for (int n = 0; n < 2; ++n) _Pragma("unroll") for (int k = 0; k < 2; ++k) dst[n][k] = *(const LAS bf16x8*)(lds + PG8_SB(b, h) + boff + n * 2048 + k * 1024); } while (0)
#define PG8_MMA(ai, bj, At, Bt) do { __builtin_amdgcn_s_setprio(1); _Pragma("unroll") for (int m = 0; m < 4; ++m) _Pragma("unroll") for (int n = 0; n < 2; ++n) _Pragma("unroll") for (int k = 0; k < 2; ++k) \
        acc[ai][bj][m][n] = __builtin_amdgcn_mfma_f32_16x16x32_bf16(Bt[n][k], At[m][k], acc[ai][bj][m][n], 0, 0, 0); __builtin_amdgcn_s_setprio(0); } while (0)
#define PG8_WAIT_V(n) asm volatile("s_waitcnt vmcnt(" #n ")" ::: "memory")
#define PG8_WAIT_L(n) asm volatile("s_waitcnt lgkmcnt(" #n ")" ::: "memory")
#define PG8_BAR __builtin_amdgcn_s_barrier()
#define PG8_SCHED __builtin_amdgcn_sched_barrier(0)
    Unit cur, nxt; int ui = 0;
    if (!S.next(0, cur)) return;
    f32x4 acc[2][2][4][2];
#pragma unroll
    for (int a = 0; a < 2; ++a)
#pragma unroll
        for (int b = 0; b < 2; ++b)
#pragma unroll
            for (int m = 0; m < 4; ++m)
#pragma unroll
                for (int n = 0; n < 2; ++n) acc[a][b][m][n] = (f32x4){0.f, 0.f, 0.f, 0.f};
    bf16x8 At[4][2], B0[2][2], B1[2][2];
    const char* cA = S.a_ptr(cur); const char* cB = S.b_ptr(cur);
    PG8_STAGE(PG8_SB(0, 0), cB, voffB); PG8_STAGE(PG8_SB(0, 1), cB + hstepB, voffB); PG8_STAGE(PG8_SA(0, 0), cA, voffA); PG8_STAGE(PG8_SA(0, 1), cA + hstepA, voffA);
    if (wr == 1) PG8_BAR;
    PG8_WAIT_V(2); PG8_BAR;
    PG8_STAGE(PG8_SB(1, 0), cB + kstep, voffB); PG8_STAGE(PG8_SA(1, 0), cA + kstep, voffA); PG8_STAGE(PG8_SB(1, 1), cB + hstepB + kstep, voffB);
    PG8_WAIT_V(6); PG8_BAR;
    for (;;) {
        if constexpr (Sched::VAR_K) { nt = S.nt(cur); asm volatile("" : "+s"(nt)); }
        const bool has_next = S.next(ui + 1, nxt);
        const char* nA = has_next ? S.a_ptr(nxt) : cA; const char* nB = has_next ? S.b_ptr(nxt) : cB;
        const char* cB2 = cB; int segT = nt;
        if constexpr (Sched::TWO_SEG) { segT = S.seg_tiles(); cB2 = S.b_ptr2(cur) - (size_t)segT * kstep; }
        for (int t = 0; t < nt; t += 2) {
            const bool last = (t == nt - 2);
            const char* a1 = cA + (size_t)(t + 1) * kstep;
            const char* bsrc = (t + 2 >= segT) ? cB2 : cB;
            const char* a2 = last ? nA : cA + (size_t)(t + 2) * kstep; const char* b2 = last ? nB : bsrc + (size_t)(t + 2) * kstep;
            const char* a3 = a2 + kstep; const char* b3 = b2 + kstep;
            PG8_LDB(B0, 0, 0); PG8_LDB(B1, 0, 1); PG8_SCHED; PG8_LDA(At, 0, 0); PG8_STAGE(PG8_SA(1, 1), a1 + hstepA, voffA);
            PG8_WAIT_V(8); PG8_WAIT_L(0); PG8_BAR; PG8_MMA(0, 0, At, B0); PG8_MMA(0, 1, At, B1); PG8_BAR; PG8_SCHED;
            PG8_LDA(At, 0, 1); PG8_STAGE(PG8_SB(0, 0), b2, voffB); PG8_STAGE(PG8_SB(0, 1), b2 + hstepB, voffB); PG8_STAGE(PG8_SA(0, 0), a2, voffA);
            PG8_WAIT_V(8); PG8_WAIT_L(0); PG8_BAR; PG8_MMA(1, 0, At, B0); PG8_MMA(1, 1, At, B1); PG8_BAR; PG8_SCHED;
            PG8_LDB(B0, 1, 0); PG8_LDB(B1, 1, 1); PG8_SCHED; PG8_LDA(At, 1, 0); PG8_STAGE(PG8_SA(0, 1), a2 + hstepA, voffA);
            PG8_WAIT_V(8); PG8_WAIT_L(0); PG8_BAR; PG8_MMA(0, 0, At, B0); PG8_MMA(0, 1, At, B1); PG8_BAR; PG8_SCHED;
            PG8_LDA(At, 1, 1); PG8_STAGE(PG8_SB(1, 0), b3, voffB); PG8_STAGE(PG8_SB(1, 1), b3 + hstepB, voffB); PG8_STAGE(PG8_SA(1, 0), a3, voffA);
            PG8_WAIT_V(8); PG8_WAIT_L(0); PG8_BAR; PG8_MMA(1, 0, At, B0); PG8_MMA(1, 1, At, B1); PG8_BAR; PG8_SCHED;
        }
        if (wr == 0) PG8_BAR;
        { const int le = lane_id_now(); E(acc, cur, wr, wc, le & 15, le >> 4); }
        if (!has_next) break;
#pragma unroll
        for (int a = 0; a < 2; ++a)
#pragma unroll
            for (int b = 0; b < 2; ++b)
#pragma unroll
                for (int m = 0; m < 4; ++m)
#pragma unroll
                    for (int n = 0; n < 2; ++n) acc[a][b][m][n] = (f32x4){0.f, 0.f, 0.f, 0.f};
        cur = nxt; cA = nA; cB = nB; ++ui;
        if (wr == 1) PG8_BAR;
    }
    PG8_WAIT_V(0);
    PG8_BAR;
#undef PG8_SA
#undef PG8_SB
#undef PG8_STAGE
#undef PG8_LDA
#undef PG8_LDB
#undef PG8_MMA
#undef PG8_WAIT_V
#undef PG8_WAIT_L
#undef PG8_BAR
#undef PG8_SCHED
}
}

constexpr size_t MiB = 1u << 20;
constexpr size_t WS_CTL = 0, CTL_ZERO_BYTES = 1 * MiB;
constexpr size_t WS_AUX = 1 * MiB;
constexpr size_t AUX_RS = WS_AUX, AUX_BKT = AUX_RS + 131072, AUX_WLO = AUX_BKT + 131072, AUX_WHI = AUX_WLO + 131072,
                 AUX_STOK = AUX_WHI + 131072, AUX_SW = AUX_STOK + 163840, AUX_TB = AUX_SW + 655360, AUX_BH = AUX_TB + 1024;
constexpr size_t WS_SGU = 2621440;
constexpr size_t WS_ROPE = 3 * MiB;
constexpr size_t WS_W = 5 * MiB;
constexpr size_t W_IN = 0, W_GATE = W_IN + (size_t)DIN * D * 2, W_BR = W_GATE + (size_t)4096 * D * 2, W_O = W_BR + (size_t)4 * D * 256 * 2,
                 W_GU = W_O + (size_t)D * D * 2, W_DN = W_GU + (size_t)NEXP * 512 * D * 2, W_LAYER = W_DN + (size_t)NEXP * D * 256 * 2;
constexpr size_t WS_BIG = 86 * MiB;
constexpr size_t BIG_GS = WS_BIG + 112 * MiB, BIG_MS = BIG_GS + 32 * MiB, BIG_MG = BIG_MS + 32 * MiB;
constexpr size_t BIG_X1 = WS_BIG, BIG_H2S = BIG_X1 + (size_t)NTOK * D * 4, BIG_HID = BIG_H2S + (size_t)MPAD_MAX * D * 2;
constexpr size_t WS_HM = 342 * MiB;
constexpr size_t WS_YS = 406 * MiB;
constexpr size_t WS_END = 470 * MiB;
static_assert(WS_W + 2 * W_LAYER <= WS_BIG && BIG_HID + (size_t)MPAD_MAX * 512 * 2 <= WS_HM && AUX_BH + 32768 <= WS_SGU && WS_SGU + 262144 <= WS_ROPE, "d_ws map");
constexpr int CW_BAR = 4096;
constexpr int CW_CNT = 8192;

constexpr int RING_BYTES = 131072;
constexpr int LDSCTL_OFF = RING_BYTES;
constexpr int LDS_BYTES = 147456;
constexpr int NWAVES = 8, NTHREADS = 512;

#define XB_TMO      128
#define XB_XCNT(j)  (256  + 64 * (j))
#define XB_XSUB(j)  (1280 + 64 * (j))
#define XB_XGEN(j)  (2304 + 64 * (j))
#define XB_TOP      3328
#define XB_TOPGEN   3392
#define XCD_BAR_WORDS 3456
#define XB_SPIN_CAP (1u << 18)

__device__ __forceinline__ unsigned xb_ld(unsigned* p)              { return __hip_atomic_load(p, __ATOMIC_RELAXED, __HIP_MEMORY_SCOPE_AGENT); }
__device__ __forceinline__ unsigned xb_add(unsigned* p, unsigned v) { return __hip_atomic_fetch_add(p, v, __ATOMIC_RELAXED, __HIP_MEMORY_SCOPE_AGENT); }
__device__ __forceinline__ unsigned xb_xcc_id() { return (unsigned)__builtin_amdgcn_s_getreg((3 << 11) | 20) & 0xFu; }
#define XB_SPIN(cond, bar) do { unsigned _sp = 0; while (cond) { __builtin_amdgcn_s_sleep(1); \
    if ((++_sp & 255u) == 0u) { if (xb_ld(&(bar)[XB_TMO])) break; if (_sp > XB_SPIN_CAP) { atomicAdd(&(bar)[XB_TMO], 1u); break; } } } } while (0)

struct XcdBarrier {
    unsigned* bar; unsigned x; int wave;
    volatile LAS unsigned* st;
};
__device__ __forceinline__ XcdBarrier xcd_barrier_post(unsigned* bar, volatile LAS unsigned* st) {
    XcdBarrier b; b.bar = bar; b.x = xb_xcc_id(); b.st = st; b.wave = __builtin_amdgcn_readfirstlane((int)threadIdx.x >> 6);
    if (threadIdx.x == 0) (void)xb_add(&bar[XB_XCNT(b.x)], 1u);
    return b;
}
__device__ __forceinline__ void xcd_barrier_complete(unsigned* bar, unsigned x, unsigned& nloc, unsigned& nx) {
    const unsigned G = gridDim.x * gridDim.y * gridDim.z;
    unsigned sum, cnt, mine, sp = 0u;
    for (;;) {
        sum = 0u; cnt = 0u; mine = 0u;
#pragma unroll
        for (unsigned j = 0; j < 16; ++j) { const unsigned c = xb_ld(&bar[XB_XCNT(j)]); sum += c; cnt += (c > 0u) ? 1u : 0u; mine = (j == x) ? c : mine; }
        if (sum == G) break;
        __builtin_amdgcn_s_sleep(1);
        if ((++sp & 255u) == 0u) { if (xb_ld(&bar[XB_TMO])) break; if (sp > XB_SPIN_CAP) { atomicAdd(&bar[XB_TMO], 1u); break; } }
    }
    nloc = mine > 0u ? mine : 1u; nx = cnt > 0u ? cnt : 1u;
}
__device__ __forceinline__ void xcd_barrier(const XcdBarrier& b) {
    asm volatile("s_waitcnt vmcnt(0)" ::: "memory");
    __syncthreads();
    if (b.wave == 0 && lane_id_now() == 0) {
        unsigned* bar = b.bar;
        __builtin_amdgcn_s_waitcnt(0);
        unsigned nloc = b.st[0], nx = b.st[1];
        if (nloc == 0u) { xcd_barrier_complete(bar, b.x, nloc, nx); b.st[0] = nloc; b.st[1] = nx; }
        const unsigned old = xb_add(&bar[XB_XSUB(b.x)], 1u);
        const unsigned gen = old / nloc;
        if (old + 1u == (gen + 1u) * nloc) {
            __builtin_amdgcn_fence(__ATOMIC_RELEASE, "agent");
            asm volatile("s_waitcnt vmcnt(0)" ::: "memory");
            const unsigned og = xb_add(&bar[XB_TOP], 1u);
            const unsigned tg = og / nx;
            if (og + 1u == (tg + 1u) * nx) xb_add(&bar[XB_TOPGEN], 1u);
            else XB_SPIN(xb_ld(&bar[XB_TOPGEN]) == tg, bar);
            __builtin_amdgcn_fence(__ATOMIC_ACQUIRE, "agent");
            xb_add(&bar[XB_XGEN(b.x)], 1u);
            asm volatile("s_waitcnt vmcnt(0)" ::: "memory");
        } else {
            XB_SPIN(xb_ld(&bar[XB_XGEN(b.x)]) == gen, bar);
            __builtin_amdgcn_fence(__ATOMIC_ACQUIRE, "agent");
            asm volatile("s_waitcnt vmcnt(0)" ::: "memory");
        }
    }
    __syncthreads();
}

struct PlainOrder {
    static constexpr bool TWO_SEG = false, VAR_K = false;
    const char* A; const char* Bt; int nM, nN, G, c; size_t tA, tB;
    __device__ __forceinline__ bool next(int i, pg8::Unit& u) const { const int L = i * G + c; if (L >= nM * nN) return false; pg8::tile_of(L, nM, nN, u.pm, u.pn); u.aux = 0; return true; }
    __device__ __forceinline__ const char* a_ptr(const pg8::Unit& u) const { return A + (size_t)u.pm * tA; }
    __device__ __forceinline__ const char* b_ptr(const pg8::Unit& u) const { return Bt + (size_t)u.pn * tB; }
};
struct BranchOrder {
    static constexpr bool TWO_SEG = false, VAR_K = false;
    const char* ys; const char* wb; int G, c;
    __device__ __forceinline__ bool next(int i, pg8::Unit& u) const { const int L = (i >> 2) * G + c; if (L >= 128 * 4) return false; pg8::tile_of(L, 128, 4, u.pm, u.pn); u.aux = i & 3; return true; }
    __device__ __forceinline__ const char* a_ptr(const pg8::Unit& u) const { return ys + (size_t)u.pm * (256 * 1024 * 2) + (size_t)u.aux * 512; }
    __device__ __forceinline__ const char* b_ptr(const pg8::Unit& u) const { return wb + (size_t)(u.aux * 1024 + u.pn * 256) * 512; }
};
struct GateMergeOrder {
    static constexpr bool TWO_SEG = false, VAR_K = true;
    const char* h; const char* ys; const char* wg; const char* wb; int G, c;
    __device__ __forceinline__ bool next(int i, pg8::Unit& u) const { const int L = (i >> 3) * G + c; if (L >= 128 * 4) return false; pg8::tile_of(L, 128, 4, u.pm, u.pn); u.aux = ((i >> 1) & 3) | ((i & 1) << 2); return true; }
    __device__ __forceinline__ int nt(const pg8::Unit& u) const { return (u.aux & 4) ? 4 : 16; }
    __device__ __forceinline__ const char* a_ptr(const pg8::Unit& u) const { return (u.aux & 4) ? ys + (size_t)u.pm * (256 * 1024 * 2) + (size_t)(u.aux & 3) * 512 : h + (size_t)u.pm * (256 * 1024 * 2); }
    __device__ __forceinline__ const char* b_ptr(const pg8::Unit& u) const { return (u.aux & 4) ? wb + (size_t)u.pn * (256 * 1024 * 2) + (size_t)(u.aux & 3) * 512 : wg + (size_t)((u.aux & 3) * 1024 + u.pn * 256) * 2048; }
};
__device__ __forceinline__ void bucket_experts(int bucket, int& e1, int& e2) {
    const int g = bucket / 6, pr = bucket - 6 * g;
    const int a = pr < 3 ? 0 : (pr < 5 ? 1 : 2), b = pr < 3 ? pr + 1 : (pr < 5 ? pr - 1 : 3);
    e1 = 4 * g + a; e2 = 4 * g + b;
}
struct MoeUpOrder {
    static constexpr bool TWO_SEG = false, VAR_K = false;
    const char* h2s; const char* wgu; unsigned* tile_bucket; int nTiles, G, vcu;
    __device__ __forceinline__ bool next(int i, pg8::Unit& u) const { const int L = i * G + vcu; if (L >= nTiles * 4) return false; u.pm = L >> 2; u.pn = L & 3;
        u.aux = __builtin_amdgcn_readfirstlane((int)__hip_atomic_load(tile_bucket + u.pm, __ATOMIC_RELAXED, __HIP_MEMORY_SCOPE_AGENT)); return true; }
    __device__ __forceinline__ const char* a_ptr(const pg8::Unit& u) const { return h2s + (size_t)u.pm * (256 * 1024 * 2); }
    __device__ __forceinline__ const char* b_ptr(const pg8::Unit& u) const { int e1, e2; bucket_experts(u.aux, e1, e2); const int e = u.pn < 2 ? e1 : e2; return wgu + (size_t)(e * 512 + (u.pn & 1) * 256) * 2048; }
};
struct MoeDownOrder {
    static constexpr bool TWO_SEG = true, VAR_K = false;
    const char* hid; const char* wdn; unsigned* tile_bucket; int nTiles, G, vcu;
    __device__ __forceinline__ bool next(int i, pg8::Unit& u) const { const int L = i * G + vcu; if (L >= nTiles * 4) return false; u.pm = L >> 2; u.pn = L & 3;
        u.aux = __builtin_amdgcn_readfirstlane((int)__hip_atomic_load(tile_bucket + u.pm, __ATOMIC_RELAXED, __HIP_MEMORY_SCOPE_AGENT)); return true; }
    __device__ __forceinline__ int seg_tiles() const { return 4; }
    __device__ __forceinline__ const char* a_ptr(const pg8::Unit& u) const { return hid + (size_t)u.pm * (256 * 512 * 2); }
    __device__ __forceinline__ const char* b_ptr(const pg8::Unit& u) const { int e1, e2; bucket_experts(u.aux, e1, e2); return wdn + (size_t)(e1 * 1024 + u.pn * 256) * 512; }
    __device__ __forceinline__ const char* b_ptr2(const pg8::Unit& u) const { int e1, e2; bucket_experts(u.aux, e1, e2); return wdn + (size_t)(e2 * 1024 + u.pn * 256) * 512; }
};

typedef f32x4 Acc[2][2][4][2];
__device__ __forceinline__ u32x4 pack8(const f32x4 a, const f32x4 b) { u32x4 w; w.x = cvt_pk_bf16(a[0], a[1]); w.y = cvt_pk_bf16(a[2], a[3]); w.z = cvt_pk_bf16(b[0], b[1]); w.w = cvt_pk_bf16(b[2], b[3]); return w; }
__device__ __forceinline__ void unpack8(const u32x4 w, f32x4& a, f32x4& b) { a = (f32x4){bf_lo(w.x), bf_hi(w.x), bf_lo(w.y), bf_hi(w.y)}; b = (f32x4){bf_lo(w.z), bf_hi(w.z), bf_lo(w.w), bf_hi(w.w)}; }

struct EpiInProj {
    static constexpr bool PERM = true;
    bf16_t* P; const float* rope; const float* qg; const float* kg;
    __device__ __forceinline__ void operator()(const Acc& acc, const pg8::Unit& u, int wr, int wc, int fr, int fq) const {
        asm volatile("" : "+v"(fr), "+v"(fq));
        const int pn = u.pn, row0 = u.pm * 256 + wr * 64 + fr, c8 = wc * 32 + 8 * fq;
        if (pn == 2 || (pn == 3 && wc < 2)) {
            const float* gp = (pn == 2) ? qg : kg; const float osc = (pn == 2) ? 0.125f : 1.0f;
            f32x4 g[2][2];
#pragma unroll
            for (int bj = 0; bj < 2; ++bj)
#pragma unroll
                for (int n = 0; n < 2; ++n) g[bj][n] = *(const f32x4*)(gp + bj * 32 + 8 * fq + 4 * n);
            const int dcol = (pn == 2 ? P_Q : P_K) + wc * 64 + 8 * fq;
#pragma unroll
            for (int ai = 0; ai < 2; ++ai)
#pragma unroll
                for (int m = 0; m < 4; ++m) {
                    const int row = row0 + ai * 128 + m * 16;
                    float ss = 0.f;
#pragma unroll
                    for (int bj = 0; bj < 2; ++bj)
#pragma unroll
                        for (int n = 0; n < 2; ++n) { const f32x4 v = acc[ai][bj][m][n]; ss += (v[0] * v[0] + v[1] * v[1]) + (v[2] * v[2] + v[3] * v[3]); }
                    ss += xor16_f(ss); ss = sum_xor32_f(ss);
                    const float rs = __builtin_amdgcn_rsqf(ss * (1.0f / 64.0f) + EPS);
                    f32x4 o[2][2];
#pragma unroll
                    for (int bj = 0; bj < 2; ++bj)
#pragma unroll
                        for (int n = 0; n < 2; ++n) o[bj][n] = acc[ai][bj][m][n] * rs * g[bj][n];
                    const float* rp = rope + (size_t)row * 16;
#pragma unroll
                    for (int n = 0; n < 2; ++n) {
                        const f32x4 cs = *(const f32x4*)(rp + 4 * n), sn = *(const f32x4*)(rp + 8 + 4 * n);
                        f32x4 other;
#pragma unroll
                        for (int j = 0; j < 4; ++j) other[j] = xor16_f(o[0][n][j]);
                        const f32x4 rot = (fq == 0) ? (o[0][n] * cs - other * sn) : (o[0][n] * cs + other * sn);
                        if (fq < 2) o[0][n] = rot;
                    }
#pragma unroll
                    for (int bj = 0; bj < 2; ++bj) *(u32x4*)(P + (size_t)row * PS + dcol + bj * 32) = pack8(o[bj][0] * osc, o[bj][1] * osc);
                }
            return;
        }
#pragma unroll
        for (int ai = 0; ai < 2; ++ai)
#pragma unroll
            for (int m = 0; m < 4; ++m) {
                bf16_t* prow = P + (size_t)(row0 + ai * 128 + m * 16) * PS;
                const f32x4 a0 = acc[ai][0][m][0], a1 = acc[ai][0][m][1], b0 = acc[ai][1][m][0], b1 = acc[ai][1][m][1];
                if (pn < 2) {
                    f32x4 x0, x1, y0, y1;
#pragma unroll
                    for (int j = 0; j < 4; ++j) { x0[j] = gelu_tanh_f(a0[j]); x1[j] = gelu_tanh_f(a1[j]); y0[j] = gelu_tanh_f(b0[j]); y1[j] = gelu_tanh_f(b1[j]); }
                    *(u32x4*)(prow + pn * 256 + c8) = pack8(x0, x1); *(u32x4*)(prow + pn * 256 + 128 + c8) = pack8(y0, y1);
                } else if (pn == 3) {
                    const int dc = P_V + (wc - 2) * 64 + 8 * fq;
                    *(u32x4*)(prow + dc) = pack8(a0, a1); *(u32x4*)(prow + dc + 32) = pack8(b0, b1);
                } else if (pn == 4 || pn == 5) {
                    *(u32x4*)(prow + P_BX + (pn - 4) * 128 + c8) = pack8(a0 * b0, a1 * b1);
                } else if (pn == 6) {
                    *(u32x4*)(prow + P_CC + c8) = pack8(a0, a1); *(u32x4*)(prow + P_CC + 128 + c8) = pack8(b0, b1);
                } else {
                    f32x4 x0, x1;
#pragma unroll
                    for (int j = 0; j < 4; ++j) { x0[j] = a0[j] * sigmoid_f(b0[j]); x1[j] = a1[j] * sigmoid_f(b1[j]); }
                    *(u32x4*)(prow + P_GLU + (pn - 7) * 128 + c8) = pack8(x0, x1);
                }
            }
    }
};
struct EpiGate {
    static constexpr bool PERM = true;
    bf16_t* Gm; const float* bias;
    __device__ __forceinline__ void operator()(const Acc& acc, const pg8::Unit& u, int wr, int wc, int fr, int fq) const {
        asm volatile("" : "+v"(fr), "+v"(fq));
        const int row0 = u.pm * 256 + wr * 64 + fr, col0 = u.pn * 256 + wc * 32 + 8 * fq;
        f32x4 bv[2][2];
#pragma unroll
        for (int bj = 0; bj < 2; ++bj)
#pragma unroll
            for (int n = 0; n < 2; ++n) bv[bj][n] = *(const f32x4*)(bias + col0 + bj * 128 + 4 * n);
#pragma unroll
        for (int ai = 0; ai < 2; ++ai)
#pragma unroll
            for (int m = 0; m < 4; ++m) { bf16_t* rowp = Gm + (size_t)(row0 + ai * 128 + m * 16) * 4096 + col0;
#pragma unroll
                for (int bj = 0; bj < 2; ++bj) { f32x4 v0 = acc[ai][bj][m][0] + bv[bj][0], v1 = acc[ai][bj][m][1] + bv[bj][1];
#pragma unroll
                    for (int j = 0; j < 4; ++j) { v0[j] = sigmoid_f(v0[j]); v1[j] = sigmoid_f(v1[j]); }
                    *(u32x4*)(rowp + bj * 128) = pack8(v0, v1); } }
    }
};
struct EpiMerge {
    static constexpr bool PERM = true;
    const bf16_t* Gm; bf16_t* Mg;
    __device__ __forceinline__ void operator()(const Acc& acc, const pg8::Unit& u, int wr, int wc, int fr, int fq) const {
        asm volatile("" : "+v"(fr), "+v"(fq));
        const int row0 = u.pm * 256 + wr * 64 + fr, col0 = u.pn * 256 + wc * 32 + 8 * fq, b = u.aux;
#pragma unroll
        for (int ai = 0; ai < 2; ++ai)
#pragma unroll
            for (int m = 0; m < 4; ++m) { const unsigned row = (unsigned)(row0 + ai * 128 + m * 16);
#pragma unroll
                for (int bj = 0; bj < 2; ++bj) {
                    f32x4 g0, g1; unpack8(*(const u32x4*)(Gm + (row * 4096u + (unsigned)(b * 1024 + col0 + bj * 128))), g0, g1);
                    f32x4 v0 = acc[ai][bj][m][0] * g0, v1 = acc[ai][bj][m][1] * g1;
                    bf16_t* mp = Mg + (row * 1024u + (unsigned)(col0 + bj * 128));
                    if (b > 0) {
                        const unsigned long long q0 = __hip_atomic_load((const unsigned long long*)mp, __ATOMIC_RELAXED, __HIP_MEMORY_SCOPE_AGENT), q1 = __hip_atomic_load((const unsigned long long*)mp + 1, __ATOMIC_RELAXED, __HIP_MEMORY_SCOPE_AGENT);
                        f32x4 p0, p1; unpack8((u32x4){(unsigned)q0, (unsigned)(q0 >> 32), (unsigned)q1, (unsigned)(q1 >> 32)}, p0, p1); v0 += p0; v1 += p1; }
                    *(u32x4*)mp = pack8(v0, v1); }
                asm volatile("" ::: "memory"); }
    }
};
__device__ __forceinline__ u32x4 ld16_nt(const bf16_t* p) { return __builtin_nontemporal_load((const u32x4*)p); }
__device__ __forceinline__ u32x4 ld16_sc1(const bf16_t* p) { const unsigned long long a = __hip_atomic_load((const unsigned long long*)p, __ATOMIC_RELAXED, __HIP_MEMORY_SCOPE_AGENT), b = __hip_atomic_load((const unsigned long long*)p + 1, __ATOMIC_RELAXED, __HIP_MEMORY_SCOPE_AGENT);
    return (u32x4){(unsigned)a, (unsigned)(a >> 32), (unsigned)b, (unsigned)(b >> 32)}; }
struct EpiGateMerge {
    static constexpr bool PERM = true;
    bf16_t* Gs; bf16_t* Ms; bf16_t* Mg; const float* bias;
    __device__ __forceinline__ void operator()(const Acc& acc, const pg8::Unit& u, int wr, int wc, int fr, int fq) const {
        asm volatile("" : "+v"(fr), "+v"(fq));
        const int b = u.aux & 3, tid = (wr * 4 + wc) * 64 + fq * 16 + fr;
        if (!(u.aux & 4)) {
            const int col0 = b * 1024 + u.pn * 256 + wc * 32 + 8 * fq;
            f32x4 bv[2][2];
#pragma unroll
            for (int bj = 0; bj < 2; ++bj)
#pragma unroll
                for (int n = 0; n < 2; ++n) bv[bj][n] = *(const f32x4*)(bias + col0 + bj * 128 + 4 * n);
#pragma unroll
            for (int ai = 0; ai < 2; ++ai)
#pragma unroll
                for (int m = 0; m < 4; ++m)
#pragma unroll
                    for (int bj = 0; bj < 2; ++bj) { f32x4 v0 = acc[ai][bj][m][0] + bv[bj][0], v1 = acc[ai][bj][m][1] + bv[bj][1];
#pragma unroll
                        for (int j = 0; j < 4; ++j) { v0[j] = sigmoid_f(v0[j]); v1[j] = sigmoid_f(v1[j]); }
                        *(u32x4*)(Gs + ((((ai * 4 + m) * 2 + bj) * 512 + tid) * 8)) = pack8(v0, v1); }
        } else {
            const int row0 = u.pm * 256 + wr * 64 + fr, col0 = u.pn * 256 + wc * 32 + 8 * fq;
#pragma unroll
            for (int ai = 0; ai < 2; ++ai) {
                u32x4 gq[4][2], pq[4][2];
#pragma unroll
                for (int m = 0; m < 4; ++m)
#pragma unroll
                    for (int bj = 0; bj < 2; ++bj) { const int ch = (((ai * 4 + m) * 2 + bj) * 512 + tid) * 8; gq[m][bj] = ld16_nt(Gs + ch); if (b > 0) pq[m][bj] = ld16_nt(Ms + ch); }
#pragma unroll
                for (int m = 0; m < 4; ++m)
#pragma unroll
                    for (int bj = 0; bj < 2; ++bj) { const int ch = (((ai * 4 + m) * 2 + bj) * 512 + tid) * 8;
                        f32x4 g0, g1; unpack8(gq[m][bj], g0, g1);
                        f32x4 v0 = acc[ai][bj][m][0] * g0, v1 = acc[ai][bj][m][1] * g1;
                        if (b > 0) { f32x4 p0, p1; unpack8(pq[m][bj], p0, p1); v0 += p0; v1 += p1; }
                        if (b < 3) *(u32x4*)(Ms + ch) = pack8(v0, v1);
                        else *(u32x4*)(Mg + ((unsigned)(row0 + ai * 128 + m * 16) * 1024u + (unsigned)(col0 + bj * 128))) = pack8(v0, v1); }
                asm volatile("" ::: "memory"); }
        }
    }
};
struct EpiWo {
    static constexpr bool PERM = true;
    const float* xin; const bf16_t* xinb; bf16_t* x1;
    __device__ __forceinline__ void operator()(const Acc& acc, const pg8::Unit& u, int wr, int wc, int fr, int fq) const {
        asm volatile("" : "+v"(fr), "+v"(fq));
        const int row0 = u.pm * 256 + wr * 64 + fr, col0 = u.pn * 256 + wc * 32 + 8 * fq;
#pragma unroll
        for (int ai = 0; ai < 2; ++ai) {
            f32x4 xr[4][2][2];
            if (xinb) {
#pragma unroll
                for (int m = 0; m < 4; ++m)
#pragma unroll
                    for (int bj = 0; bj < 2; ++bj) unpack8(*(const u32x4*)(xinb + ((unsigned)(row0 + ai * 128 + m * 16) * 1024u + (unsigned)(col0 + bj * 128))), xr[m][bj][0], xr[m][bj][1]);
            } else {
#pragma unroll
                for (int m = 0; m < 4; ++m)
#pragma unroll
                    for (int bj = 0; bj < 2; ++bj)
#pragma unroll
                        for (int n = 0; n < 2; ++n) xr[m][bj][n] = *(const f32x4*)(xin + ((unsigned)(row0 + ai * 128 + m * 16) * 1024u + (unsigned)(col0 + bj * 128 + 4 * n)));
            }
#pragma unroll
            for (int m = 0; m < 4; ++m)
#pragma unroll
                for (int bj = 0; bj < 2; ++bj) *(u32x4*)(x1 + ((unsigned)(row0 + ai * 128 + m * 16) * 1024u + (unsigned)(col0 + bj * 128))) = pack8(xr[m][bj][0] + acc[ai][bj][m][0], xr[m][bj][1] + acc[ai][bj][m][1]);
            asm volatile("" ::: "memory"); }
    }
};
struct EpiMoeUp {
    static constexpr bool PERM = true;
    bf16_t* hid; const float* slot_w;
    __device__ __forceinline__ void operator()(const Acc& acc, const pg8::Unit& u, int wr, int wc, int fr, int fq) const {
        asm volatile("" : "+v"(fr), "+v"(fq));
        const int row0 = u.pm * 256 + wr * 64 + fr, col0 = (u.pn >> 1) * 256 + (u.pn & 1) * 128 + wc * 32 + 8 * fq, k = u.pn >> 1;
#pragma unroll
        for (int ai = 0; ai < 2; ++ai)
#pragma unroll
            for (int m = 0; m < 4; ++m) { const size_t row = (size_t)(row0 + ai * 128 + m * 16); const f32x4 sw = *(const f32x4*)(slot_w + row * 4); const float w = (k ? sw[1] : sw[0]) * sw[2] * sw[2], rs = sw[2];
                f32x4 x0, x1; const f32x4 a0 = acc[ai][0][m][0], a1 = acc[ai][0][m][1], b0 = acc[ai][1][m][0], b1 = acc[ai][1][m][1];
#pragma unroll
                for (int j = 0; j < 4; ++j) { x0[j] = a0[j] * sigmoid_f(a0[j] * rs) * b0[j] * w; x1[j] = a1[j] * sigmoid_f(a1[j] * rs) * b1[j] * w; }
                *(u32x4*)(hid + row * 512 + col0) = pack8(x0, x1); }
    }
};
struct EpiMoeDown {
    static constexpr bool PERM = true;
    const int* slot_tok; const bf16_t* x1; float* out; bf16_t* outb;
    __device__ __forceinline__ void operator()(const Acc& acc, const pg8::Unit& u, int wr, int wc, int fr, int fq) const {
        asm volatile("" : "+v"(fr), "+v"(fq));
        const int row0 = u.pm * 256 + wr * 64 + fr, col0 = u.pn * 256 + wc * 32 + 8 * fq;
        int tk[2][4];
#pragma unroll
        for (int ai = 0; ai < 2; ++ai)
#pragma unroll
            for (int m = 0; m < 4; ++m) tk[ai][m] = slot_tok[row0 + ai * 128 + m * 16];
#pragma unroll
        for (int ai = 0; ai < 2; ++ai) {
            u32x4 xr[4][2];
#pragma unroll
            for (int m = 0; m < 4; ++m) { const unsigned ro = (unsigned)(tk[ai][m] < 0 ? 0 : tk[ai][m]) * 1024u + (unsigned)col0;
#pragma unroll
                for (int bj = 0; bj < 2; ++bj) xr[m][bj] = *(const u32x4*)(x1 + (ro + bj * 128)); }
#pragma unroll
            for (int m = 0; m < 4; ++m) if (tk[ai][m] >= 0) { const unsigned ro = (unsigned)tk[ai][m] * 1024u + (unsigned)col0;
#pragma unroll
                for (int bj = 0; bj < 2; ++bj) { f32x4 r0, r1; unpack8(xr[m][bj], r0, r1);
                    const f32x4 v0 = r0 + ((ABL & 16) ? acc[ai][bj][m][0] * 0.f : acc[ai][bj][m][0]), v1 = r1 + ((ABL & 16) ? acc[ai][bj][m][1] * 0.f : acc[ai][bj][m][1]);
                    if (outb) *(u32x4*)(outb + (ro + bj * 128)) = pack8(v0, v1);
                    else { *(f32x4*)(out + (ro + bj * 128)) = v0; *(f32x4*)(out + (ro + bj * 128 + 4)) = v1; } } }
            asm volatile("" ::: "memory"); }
    }
};

enum InIdx { I_X = 0, I_POS, I_N1G, I_WIN, I_SLNG, I_SLNB, I_SGUW, I_SGUB, I_QNG, I_KNG, I_SINK, I_C3W, I_C31W, I_C31B, I_CNG, I_CNB, I_WBR, I_WGATE, I_BGATE, I_WO,
             I_N2G, I_WGRP, I_BGRP, I_WEXP, I_BEXP, I_WEG, I_WEU, I_WED, N_IN };
struct Args { const void* in[N_IN]; float* out; unsigned char* ws; int ph_lo, ph_hi; };
struct Frame {
    LAS unsigned char* lds; unsigned char* ws; unsigned* ctl;
    int tid, lane, wave, vcu, G;
};
#define LDS_WAIT() asm volatile("s_waitcnt lgkmcnt(0)" ::: "memory")

__device__ __forceinline__ void p0_transpose_item(const float* W, int N, bf16_t* WT, int Kd, int k0, int n0, int drow0, LAS float* scr, int lane, int kd0 = -1, const float* ksc = nullptr) {
    if (kd0 < 0) kd0 = k0;
#pragma unroll 8
    for (int i = 0; i < 32; ++i) { const int kk = 2 * i + (lane >> 5); const float sc = ksc ? ksc[k0 + kk] : 1.0f; scr[kk * 33 + (lane & 31)] = W[(size_t)(k0 + kk) * N + n0 + (lane & 31)] * sc; }
    LDS_WAIT(); asm volatile("" ::: "memory");
    const int c = lane & 7;
#pragma unroll
    for (int j = 0; j < 4; ++j) { const int n = (lane >> 3) + 8 * j; const LAS float* s = scr + (8 * c) * 33 + n;
        u32x4 o; o.x = cvt_pk_bf16(s[0 * 33], s[1 * 33]); o.y = cvt_pk_bf16(s[2 * 33], s[3 * 33]); o.z = cvt_pk_bf16(s[4 * 33], s[5 * 33]); o.w = cvt_pk_bf16(s[6 * 33], s[7 * 33]);
        *(u32x4*)(WT + (size_t)(drow0 + n) * Kd + kd0 + 8 * c) = o; }
    LDS_WAIT(); asm volatile("" ::: "memory");
}
__device__ __forceinline__ int win_dest_row(int s0) {
    if (s0 < 512) return s0;
    if (s0 < 768)  { const int r = s0 - 512, h = r >> 6, bj = (r >> 5) & 1; return 512 + 128 * bj + 32 * h; }
    if (s0 < 896)  { const int r = s0 - 768, h = r >> 6, bj = (r >> 5) & 1; return 768 + 128 * bj + 32 * h; }
    if (s0 < 1024) { const int r = s0 - 896, h = r >> 6, bj = (r >> 5) & 1; return 768 + 128 * bj + 32 * (h + 2); }
    if (s0 < 1280) { const int ch = s0 - 1024; return (4 + (ch >> 7)) * 256 + (ch & 127); }
    if (s0 < 1536) return 6 * 256 + (s0 - 1280);
    if (s0 < 1792) { const int ch = s0 - 1536; return (4 + (ch >> 7)) * 256 + 128 + (ch & 127); }
    if (s0 < 2048) { const int ch = s0 - 1792; return (7 + (ch >> 7)) * 256 + (ch & 127); }
    { const int ch = s0 - 2048; return (7 + (ch >> 7)) * 256 + 128 + (ch & 127); }
}
constexpr int IT_WIN = 16 * 72, IT_WGATE = 16 * 128, IT_WBR = 4 * 4 * 32, IT_WO = 16 * 32, IT_EG = 16 * 16 * 8, IT_EU = IT_EG, IT_ED = 16 * 4 * 32;
constexpr int IT_LAYER = IT_WIN + IT_WGATE + IT_WBR + IT_WO + IT_EG + IT_EU + IT_ED;
__device__ __forceinline__ void p0_weights(const Frame& F0, const Args& a) {
    Frame F = F0; F.lane = lane_id_now(); F.tid = F.wave * 64 + F.lane; asm volatile("" : "+s"(F.G), "+s"(F.vcu));
    LAS float* scr = (LAS float*)(F.lds + F.wave * 16384);
    const int gw = F.vcu * NWAVES + F.wave, NGW = F.G * NWAVES;
    for (int it = gw; it < DEPTH * IT_LAYER; it += NGW) {
        const int l = it / IT_LAYER; int r = it - l * IT_LAYER;
        unsigned char* wl = F.ws + WS_W + (size_t)l * W_LAYER;
        if (r < IT_WIN) { const int kb = r / 72, nb = r % 72; p0_transpose_item((const float*)a.in[I_WIN] + (size_t)l * D * DIN, DIN, (bf16_t*)(wl + W_IN), D, 64 * kb, 32 * nb, win_dest_row(32 * nb), scr, F.lane); continue; } r -= IT_WIN;
        if (r < IT_WGATE) { const int kb = r / 128, nb = r % 128; p0_transpose_item((const float*)a.in[I_WGATE] + (size_t)l * D * 4096, 4096, (bf16_t*)(wl + W_GATE), D, 64 * kb, 32 * nb, 32 * nb, scr, F.lane); continue; } r -= IT_WGATE;
        if (r < IT_WBR) { const int b = r / 128, q = r % 128, kb = q / 32, nb = q % 32; p0_transpose_item((const float*)a.in[I_WBR] + ((size_t)l * 4 + b) * 256 * D, D, (bf16_t*)(wl + W_BR), 1024, 64 * kb, 32 * nb, 32 * nb, scr, F.lane, b * 256 + 64 * kb); continue; } r -= IT_WBR;
        if (r < IT_WO) { const int kb = r / 32, nb = r % 32; p0_transpose_item((const float*)a.in[I_WO] + (size_t)l * D * D, D, (bf16_t*)(wl + W_O), D, 64 * kb, 32 * nb, 32 * nb, scr, F.lane); continue; } r -= IT_WO;
        if (r < IT_EG + IT_EU) { const int up = r >= IT_EG; if (up) r -= IT_EG; const int e = r / 128, q = r % 128, kb = q / 8, nb = q % 8, f0 = 32 * nb;
            const float* src = (const float*)a.in[up ? I_WEU : I_WEG] + ((size_t)l * NEXP + e) * D * DEXP;
            p0_transpose_item(src, DEXP, (bf16_t*)(wl + W_GU), D, 64 * kb, f0, e * 512 + (f0 >> 7) * 256 + up * 128 + (f0 & 127), scr, F.lane, -1, (const float*)a.in[I_N2G] + (size_t)l * D); continue; } r -= IT_EG + IT_EU;
        { const int e = r / 128, q = r % 128, kb = q / 32, nb = q % 32;
          p0_transpose_item((const float*)a.in[I_WED] + ((size_t)l * NEXP + e) * DEXP * D, D, (bf16_t*)(wl + W_DN), DEXP, 64 * kb, 32 * nb, e * 1024 + 32 * nb, scr, F.lane); }
    }
    const int gt = F.vcu * NTHREADS + F.tid, NGT = F.G * NTHREADS;
    float* rope = (float*)(F.ws + WS_ROPE); const int* pos = (const int*)a.in[I_POS];
    for (int idx = gt; idx < NTOK * 8; idx += NGT) { const int t = idx >> 3, i = idx & 7;
        const float inv = (float)exp2(-(double)i * (18.931568569324174 / 8.0));
        const float ang = (float)pos[t] * inv; float s, c; sincosf(ang, &s, &c);
        rope[(size_t)t * 16 + i] = c; rope[(size_t)t * 16 + 8 + i] = s; }
    bf16_t* sg = (bf16_t*)(F.ws + WS_SGU); const float* sw = (const float*)a.in[I_SGUW];
    for (int idx = gt; idx < DEPTH * 4 * 128 * 128 / 2; idx += NGT) { const int e = idx * 2, s = e & 127, t = (e >> 7) & 127;
        const float v0 = (s <= t) ? sw[e] : 0.f, v1 = (s + 1 <= t) ? sw[e + 1] : 0.f; ((unsigned*)sg)[idx] = cvt_pk_bf16(v0, v1); }
}
__device__ __forceinline__ void norm_rows(const Frame& F0, const float* x, const float* g, bf16_t* h) {
    Frame F = F0; F.lane = lane_id_now(); F.tid = F.wave * 64 + F.lane; asm volatile("" : "+s"(F.G), "+s"(F.vcu));
    const int gw = F.vcu * NWAVES + F.wave, NGW = F.G * NWAVES;
    f32x4 gv[4];
#pragma unroll
    for (int j = 0; j < 4; ++j) gv[j] = *((const f32x4*)g + F.lane + 64 * j);
    for (int m = gw; m < NTOK; m += NGW) {
        const f32x4* xr = (const f32x4*)(x + (size_t)m * D) + F.lane;
        f32x4 v[4]; float s = 0.f;
#pragma unroll
        for (int j = 0; j < 4; ++j) { v[j] = xr[64 * j]; s += (v[j][0] * v[j][0] + v[j][1] * v[j][1]) + (v[j][2] * v[j][2] + v[j][3] * v[j][3]); }
        const float rs = 1.0f / sqrtf(wave_sum(s) * (1.0f / D) + EPS);
        u32x2* o8 = (u32x2*)(h + (size_t)m * D) + F.lane;
#pragma unroll
        for (int j = 0; j < 4; ++j) { const f32x4 y = v[j] * rs * gv[j]; u32x2 o; o.x = cvt_pk_bf16(y[0], y[1]); o.y = cvt_pk_bf16(y[2], y[3]); o8[64 * j] = o; }
    }
}

__device__ __forceinline__ void norm_rows_bf16(const Frame& F0, const bf16_t* x, const float* g, bf16_t* h) {
    Frame F = F0; F.lane = lane_id_now(); F.tid = F.wave * 64 + F.lane; asm volatile("" : "+s"(F.G), "+s"(F.vcu));
    const int gw = F.vcu * NWAVES + F.wave, NGW = F.G * NWAVES;
    f32x4 g0[2], g1[2];
#pragma unroll
    for (int j = 0; j < 2; ++j) { g0[j] = *(const f32x4*)(g + 8 * (F.lane + 64 * j)); g1[j] = *(const f32x4*)(g + 8 * (F.lane + 64 * j) + 4); }
    for (int m = gw; m < NTOK; m += NGW) {
        const u32x4* xr = (const u32x4*)(x + (size_t)m * D) + F.lane;
        f32x4 v0[2], v1[2]; float s = 0.f;
#pragma unroll
        for (int j = 0; j < 2; ++j) { unpack8(xr[64 * j], v0[j], v1[j]); s += (v0[j][0] * v0[j][0] + v0[j][1] * v0[j][1]) + (v0[j][2] * v0[j][2] + v0[j][3] * v0[j][3]) + (v1[j][0] * v1[j][0] + v1[j][1] * v1[j][1]) + (v1[j][2] * v1[j][2] + v1[j][3] * v1[j][3]); }
        const float rs = 1.0f / sqrtf(wave_sum(s) * (1.0f / D) + EPS);
        u32x4* o = (u32x4*)(h + (size_t)m * D) + F.lane;
#pragma unroll
        for (int j = 0; j < 2; ++j) o[64 * j] = pack8(v0[j] * rs * g0[j], v1[j] * rs * g1[j]);
    }
}

struct MixArgs { const bf16_t* P; bf16_t* ys; const bf16_t* sgw; const float *sln_g, *sln_b, *sgu_w, *sgu_b, *sinks, *c3w, *c31w, *c31b, *cn_g, *cn_b; };

typedef float f32x16 __attribute__((ext_vector_type(16)));
__device__ __forceinline__ float max_xor32_f(float v) { const auto r = __builtin_amdgcn_permlane32_swap(__float_as_uint(v), __float_as_uint(v), false, false); return fmaxf(__uint_as_float(r[0]), __uint_as_float(r[1])); }
__device__ __forceinline__ void mix_sgu(const Frame& F0, const MixArgs& A, int t0) {
    Frame F = F0; F.lane = lane_id_now(); F.tid = F.wave * 64 + F.lane;
    LAS bf16_t* vT = (LAS bf16_t*)F.lds;
    const int w = F.wave, lane = F.lane;
    {
        const int tp = lane & 7, cg = lane >> 3;
        const bf16_t* r0 = A.P + (size_t)(t0 + 16 * w + 2 * tp) * PS + P_GV + 32 * cg;
        float x0[32], x1[32];
#pragma unroll
        for (int c = 0; c < 4; ++c) { const u32x4 a = *((const u32x4*)r0 + c), b = *((const u32x4*)(r0 + PS) + c);
            x0[8 * c + 0] = bf_lo(a.x); x0[8 * c + 1] = bf_hi(a.x); x0[8 * c + 2] = bf_lo(a.y); x0[8 * c + 3] = bf_hi(a.y); x0[8 * c + 4] = bf_lo(a.z); x0[8 * c + 5] = bf_hi(a.z); x0[8 * c + 6] = bf_lo(a.w); x0[8 * c + 7] = bf_hi(a.w);
            x1[8 * c + 0] = bf_lo(b.x); x1[8 * c + 1] = bf_hi(b.x); x1[8 * c + 2] = bf_lo(b.y); x1[8 * c + 3] = bf_hi(b.y); x1[8 * c + 4] = bf_lo(b.z); x1[8 * c + 5] = bf_hi(b.z); x1[8 * c + 6] = bf_lo(b.w); x1[8 * c + 7] = bf_hi(b.w); }
        float s0 = 0.f, s1 = 0.f;
#pragma unroll
        for (int k = 0; k < 32; ++k) { s0 += x0[k]; s1 += x1[k]; }
        s0 += dpp_f<0x128>(s0); s0 += xor16_f(s0); s0 = sum_xor32_f(s0);
        s1 += dpp_f<0x128>(s1); s1 += xor16_f(s1); s1 = sum_xor32_f(s1);
        const float m0 = s0 * (1.0f / 256.0f), m1 = s1 * (1.0f / 256.0f);
        float q0 = 0.f, q1 = 0.f;
#pragma unroll
        for (int k = 0; k < 32; ++k) { x0[k] -= m0; x1[k] -= m1; q0 += x0[k] * x0[k]; q1 += x1[k] * x1[k]; }
        q0 += dpp_f<0x128>(q0); q0 += xor16_f(q0); q0 = sum_xor32_f(q0);
        q1 += dpp_f<0x128>(q1); q1 += xor16_f(q1); q1 = sum_xor32_f(q1);
        const float rs0 = 1.0f / sqrtf(q0 * (1.0f / 256.0f) + EPS), rs1 = 1.0f / sqrtf(q1 * (1.0f / 256.0f) + EPS);
        LAS unsigned* wp = (LAS unsigned*)(vT + (32 * cg) * 136 + 16 * w + 2 * tp);
#pragma unroll
        for (int c = 0; c < 8; ++c) { const f32x4 g = *(const f32x4*)(A.sln_g + 32 * cg + 4 * c), bb = *(const f32x4*)(A.sln_b + 32 * cg + 4 * c);
#pragma unroll
            for (int j = 0; j < 4; ++j) { const int k = 4 * c + j; wp[k * 68] = cvt_pk_bf16(x0[k] * rs0 * g[j] + bb[j], x1[k] * rs1 * g[j] + bb[j]); } }
    }
    __syncthreads();
    const int fr = lane & 15, fq = lane >> 4, t = 16 * w + fr, nks = (w >> 1) + 1;
    bf16x8 bw[4][4]; u32x2 uw[4][4]; float bias[4];
#pragma unroll
    for (int g = 0; g < 4; ++g) { const bf16_t* wrow = A.sgw + (size_t)(g * 128 + t) * 128 + 8 * fq;
#pragma unroll
        for (int ks = 0; ks < 4; ++ks) if (ks < nks) bw[g][ks] = *(const bf16x8*)(wrow + 32 * ks);
#pragma unroll
        for (int ct = 0; ct < 4; ++ct) uw[g][ct] = *(const u32x2*)(A.P + (size_t)(t0 + t) * PS + P_U + g * 64 + 16 * ct + 4 * fq);
        bias[g] = A.sgu_b[g * 128 + t]; }
#pragma unroll
    for (int g = 0; g < 4; ++g) {
        f32x4 acc[4];
#pragma unroll
        for (int ct = 0; ct < 4; ++ct) acc[ct] = (f32x4){0.f, 0.f, 0.f, 0.f};
        const LAS bf16_t* vrow = vT + (g * 64 + fr) * 136 + 8 * fq;
#pragma unroll
        for (int ks = 0; ks < 4; ++ks) if (ks < nks) {
#pragma unroll
            for (int ct = 0; ct < 4; ++ct) { const bf16x8 av = *(const LAS bf16x8*)(vrow + ct * 16 * 136 + 32 * ks); acc[ct] = __builtin_amdgcn_mfma_f32_16x16x32_bf16(av, bw[g][ks], acc[ct], 0, 0, 0); } }
#pragma unroll
        for (int ct = 0; ct < 4; ++ct) { const int c = g * 64 + 16 * ct + 4 * fq; const u32x2 u2 = uw[g][ct];
            u32x2 o; o.x = cvt_pk_bf16(bf_lo(u2.x) * (acc[ct][0] + bias[g]), bf_hi(u2.x) * (acc[ct][1] + bias[g])); o.y = cvt_pk_bf16(bf_lo(u2.y) * (acc[ct][2] + bias[g]), bf_hi(u2.y) * (acc[ct][3] + bias[g]));
            *(u32x2*)(A.ys + (size_t)(t0 + t) * 1024 + c) = o; }
    }
    __syncthreads();
}
__device__ __forceinline__ void mix_attn(const Frame& F0, const MixArgs& A, int t0, bool first) {
    Frame F = F0; F.lane = lane_id_now(); F.tid = F.wave * 64 + F.lane;
    LAS bf16_t* Ks = (LAS bf16_t*)F.lds;
    LAS bf16_t* Vt = (LAS bf16_t*)(F.lds + 36864);
    const int w = F.wave, lane = F.lane, l31 = lane & 31, h = lane >> 5;
    u32x4 kreg[4], vreg[2][2];
#define ATT_LOAD(hk_) do { _Pragma("unroll") for (int i_ = 0; i_ < 4; ++i_) { const int idx = F.tid + i_ * NTHREADS, j = idx >> 3, ch = idx & 7; \
            kreg[i_] = (first && j < 128) ? (u32x4){0u, 0u, 0u, 0u} : *(const u32x4*)(A.P + (size_t)(t0 - 128 + j) * PS + P_K + (hk_) * 64 + ch * 8); } \
        _Pragma("unroll") for (int i_ = 0; i_ < 2; ++i_) { const int it = F.tid + i_ * NTHREADS, kp = it & 127, dg = it >> 7; \
            if (first && kp < 64) { vreg[i_][0] = (u32x4){0u, 0u, 0u, 0u}; vreg[i_][1] = vreg[i_][0]; } \
            else { const bf16_t* src = A.P + (size_t)(t0 - 128 + 2 * kp) * PS + P_V + (hk_) * 64 + dg * 8; vreg[i_][0] = *(const u32x4*)src; vreg[i_][1] = *(const u32x4*)(src + PS); } } } while (0)
#define ATT_WRITE() do { _Pragma("unroll") for (int i_ = 0; i_ < 4; ++i_) { const int idx = F.tid + i_ * NTHREADS, j = idx >> 3, ch = idx & 7; *(LAS u32x4*)(Ks + j * 72 + ch * 8) = kreg[i_]; } \
        _Pragma("unroll") for (int i_ = 0; i_ < 2; ++i_) { const int it = F.tid + i_ * NTHREADS, kp = it & 127, dg = it >> 7; const u32x4 v0 = vreg[i_][0], v1 = vreg[i_][1]; \
            LAS unsigned* dst = (LAS unsigned*)(Vt + (8 * dg) * 260 + 2 * kp); \
            dst[0 * 130] = (v0.x & 0xffffu) | (v1.x << 16); dst[1 * 130] = (v0.x >> 16) | (v1.x & 0xffff0000u); \
            dst[2 * 130] = (v0.y & 0xffffu) | (v1.y << 16); dst[3 * 130] = (v0.y >> 16) | (v1.y & 0xffff0000u); \
            dst[4 * 130] = (v0.z & 0xffffu) | (v1.z << 16); dst[5 * 130] = (v0.z >> 16) | (v1.z & 0xffff0000u); \
            dst[6 * 130] = (v0.w & 0xffffu) | (v1.w << 16); dst[7 * 130] = (v0.w >> 16) | (v1.w & 0xffff0000u); } } while (0)
    ATT_LOAD(0);
#pragma unroll
    for (int hk = 0; hk < 2; ++hk) {
        __syncthreads();
        ATT_WRITE();
        if (hk == 0) ATT_LOAD(1);
        __syncthreads();
        const int head = 2 * hk + (w >> 2), qb = w & 3, qi = 32 * qb + l31;
        bf16x8 bq[4];
        { const bf16_t* qp = A.P + (size_t)(t0 + qi) * PS + P_Q + head * 64 + 8 * h;
#pragma unroll
          for (int ks = 0; ks < 4; ++ks) bq[ks] = *(const bf16x8*)(qp + 16 * ks); }
        f32x16 sc[5];
#pragma unroll
        for (int it = 0; it < 5; ++it) {
#pragma unroll
            for (int r = 0; r < 16; ++r) sc[it][r] = 0.f;
            const LAS bf16_t* kp = Ks + (32 * (qb + it) + l31) * 72 + 8 * h;
#pragma unroll
            for (int ks = 0; ks < 4; ++ks) sc[it] = __builtin_amdgcn_mfma_f32_32x32x16_bf16(*(const LAS bf16x8*)(kp + 16 * ks), bq[ks], sc[it], 0, 0, 0); }
        const float sink = A.sinks[head];
        float mx = sink;
        int qiv = qi; asm volatile("" : "+v"(qiv));
#pragma unroll
        for (int it = 0; it < 5; ++it) {
            const bool dead = first && (qb + it) < 4;
#pragma unroll
            for (int r = 0; r < 16; ++r) { const int kb = 32 * (qb + it) + (r & 3) + 8 * (r >> 2) + 4 * h;
                bool valid = !dead;
                if (it == 0) valid = valid && (kb > qiv);
                if (it == 4) valid = valid && (kb <= qiv + 128);
                const float v = valid ? sc[it][r] : -INFINITY; sc[it][r] = v; mx = fmaxf(mx, v); } }
        mx = max_xor32_f(mx);
        float l = 0.f;
#pragma unroll
        for (int it = 0; it < 5; ++it)
#pragma unroll
            for (int r = 0; r < 16; ++r) { const float p = __builtin_amdgcn_exp2f((sc[it][r] - mx) * 1.44269504089f); sc[it][r] = p; l += p; }
        l = sum_xor32_f(l) + __builtin_amdgcn_exp2f((sink - mx) * 1.44269504089f);
        f32x16 o[2];
#pragma unroll
        for (int dt = 0; dt < 2; ++dt)
#pragma unroll
            for (int r = 0; r < 16; ++r) o[dt][r] = 0.f;
#pragma unroll
        for (int it = 0; it < 5; ++it)
#pragma unroll
            for (int st = 0; st < 2; ++st) {
                union { u32x4 u; bf16x8 v; } pb;
                pb.u.x = cvt_pk_bf16(sc[it][8 * st + 0], sc[it][8 * st + 1]); pb.u.y = cvt_pk_bf16(sc[it][8 * st + 2], sc[it][8 * st + 3]);
                pb.u.z = cvt_pk_bf16(sc[it][8 * st + 4], sc[it][8 * st + 5]); pb.u.w = cvt_pk_bf16(sc[it][8 * st + 6], sc[it][8 * st + 7]);
#pragma unroll
                for (int dt = 0; dt < 2; ++dt) { const LAS bf16_t* vp = Vt + (32 * dt + l31) * 260 + 32 * (qb + it) + 16 * st + 4 * h;
                    union { u32x4 u; bf16x8 v; } va; const u32x2 lo = *(const LAS u32x2*)vp, hi = *(const LAS u32x2*)(vp + 8);
                    va.u = (u32x4){lo.x, lo.y, hi.x, hi.y};
                    o[dt] = __builtin_amdgcn_mfma_f32_32x32x16_bf16(va.v, pb.v, o[dt], 0, 0, 0); } }
        const float il = 1.0f / l;
        bf16_t* op = A.ys + (size_t)(t0 + qi) * 1024 + 256 + head * 64 + 4 * h;
#pragma unroll
        for (int dt = 0; dt < 2; ++dt)
#pragma unroll
            for (int g4 = 0; g4 < 4; ++g4) { u32x2 ov; ov.x = cvt_pk_bf16(o[dt][4 * g4] * il, o[dt][4 * g4 + 1] * il); ov.y = cvt_pk_bf16(o[dt][4 * g4 + 2] * il, o[dt][4 * g4 + 3] * il);
                *(u32x2*)(op + 32 * dt + 8 * g4) = ov; }
    }
    __syncthreads();
#undef ATT_LOAD
#undef ATT_WRITE
}
__device__ __forceinline__ void mix_conv3(const Frame& F0, const MixArgs& A, int t0, bool first) {
    Frame F = F0; F.lane = lane_id_now(); F.tid = F.wave * 64 + F.lane;
    const int c8 = (F.tid & 31) * 8, tq = (F.tid >> 5) * 8;
    f32x4 w[3][2];
#pragma unroll
    for (int j = 0; j < 3; ++j) { w[j][0] = *(const f32x4*)(A.c3w + j * 256 + c8); w[j][1] = *(const f32x4*)(A.c3w + j * 256 + c8 + 4); }
    f32x4 x[10][2];
#pragma unroll
    for (int r = 0; r < 10; ++r) { const int t = tq - 2 + r;
        if (t < 0 && first) { x[r][0] = (f32x4){0.f, 0.f, 0.f, 0.f}; x[r][1] = x[r][0]; }
        else unpack8(*(const u32x4*)(A.P + (size_t)(t0 + t) * PS + P_BX + c8), x[r][0], x[r][1]); }
#pragma unroll
    for (int i = 0; i < 8; ++i) { f32x4 cc0, cc1; unpack8(*(const u32x4*)(A.P + (size_t)(t0 + tq + i) * PS + P_CC + c8), cc0, cc1);
        const f32x4 y0 = w[0][0] * x[i][0] + w[1][0] * x[i + 1][0] + w[2][0] * x[i + 2][0], y1 = w[0][1] * x[i][1] + w[1][1] * x[i + 1][1] + w[2][1] * x[i + 2][1];
        *(u32x4*)(A.ys + (size_t)(t0 + tq + i) * 1024 + 512 + c8) = pack8(cc0 * y0, cc1 * y1); }
}
__device__ __forceinline__ void mix_conv31(const Frame& F0, const MixArgs& A, int t0, bool first) {
    Frame F = F0; F.lane = lane_id_now(); F.tid = F.wave * 64 + F.lane;
    LAS bf16_t* gl = (LAS bf16_t*)F.lds;
    LAS float* wl = (LAS float*)(F.lds + 158 * 512);
    {   u32x4 v[10];
#pragma unroll
        for (int i = 0; i < 10; ++i) { const int idx = F.tid + i * NTHREADS, r = idx >> 5, ch = idx & 31;
            v[i] = (idx < 158 * 32 && !(first && r < 30)) ? *(const u32x4*)(A.P + (size_t)(t0 - 30 + r) * PS + P_GLU + ch * 8) : (u32x4){0u, 0u, 0u, 0u}; }
        f32x4 wv[4];
#pragma unroll
        for (int i = 0; i < 4; ++i) { const int idx = F.tid + i * NTHREADS; wv[i] = (idx < 31 * 64) ? *((const f32x4*)A.c31w + idx) : (f32x4){0.f, 0.f, 0.f, 0.f}; }
#pragma unroll
        for (int i = 0; i < 10; ++i) { const int idx = F.tid + i * NTHREADS; if (idx < 158 * 32) *(LAS u32x4*)(gl + (idx >> 5) * 256 + (idx & 31) * 8) = v[i]; }
#pragma unroll
        for (int i = 0; i < 4; ++i) { const int idx = F.tid + i * NTHREADS; if (idx < 31 * 64) *((LAS f32x4*)wl + idx) = wv[i]; }
    }
    __syncthreads();
    const int c4 = F.lane * 4, tr = F.wave * 16;
    const f32x4 bias = *(const f32x4*)(A.c31b + c4), g = *(const f32x4*)(A.cn_g + c4), b = *(const f32x4*)(A.cn_b + c4);
    f32x4 acc[16];
#pragma unroll
    for (int i = 0; i < 16; ++i) acc[i] = bias;
#pragma unroll 2
    for (int j = 0; j < 31; ++j) { const f32x4 w = *(const LAS f32x4*)(wl + j * 256 + c4);
        const LAS bf16_t* xp = gl + (tr + j) * 256 + c4;
#pragma unroll
        for (int i = 0; i < 16; ++i) { const u32x2 p = *(const LAS u32x2*)(xp + i * 256); acc[i] += w * (f32x4){bf_lo(p.x), bf_hi(p.x), bf_lo(p.y), bf_hi(p.y)}; } }
#pragma unroll
    for (int i = 0; i < 16; ++i) {
        f32x4 v = acc[i];
        const float mean = wave_sum((v[0] + v[1]) + (v[2] + v[3])) * (1.0f / 256.0f);
        v = v - mean;
        const float var = wave_sum((v[0] * v[0] + v[1] * v[1]) + (v[2] * v[2] + v[3] * v[3])) * (1.0f / 256.0f);
        const float rstd = 1.0f / sqrtf(var + EPS);
        v = v * rstd * g + b;
        u32x2 o; o.x = cvt_pk_bf16(silu_f(v[0]), silu_f(v[1])); o.y = cvt_pk_bf16(silu_f(v[2]), silu_f(v[3]));
        *(u32x2*)(A.ys + (size_t)(t0 + tr + i) * 1024 + 768 + c4) = o; }
    __syncthreads();
}
__device__ __forceinline__ void mixer_phase(const Frame& F0, const MixArgs& A) {
    Frame F = F0; F.lane = lane_id_now(); F.tid = F.wave * 64 + F.lane; asm volatile("" : "+s"(F.G), "+s"(F.vcu));
    for (int ch = F.vcu; ch < NTOK / 128; ch += F.G) {
        const int t0 = ch * 128; const bool first = (ch % (SEQ / 128)) == 0;
        #ifndef MIX_MASK
#define MIX_MASK 15
#endif
        if (MIX_MASK & 1) mix_sgu(F, A, t0); if (MIX_MASK & 2) mix_attn(F, A, t0, first); if (MIX_MASK & 4) mix_conv3(F, A, t0, first); if (MIX_MASK & 8) mix_conv31(F, A, t0, first);
        if (ABL & 15) { __syncthreads(); for (int idx = F.tid; idx < 128 * 128; idx += NTHREADS) { const int r = idx >> 7, c8 = (idx & 127) * 8, br = c8 >> 8;
            if ((ABL >> br) & 1) *(u32x4*)(A.ys + (size_t)(t0 + r) * 1024 + c8) = (u32x4){0u, 0u, 0u, 0u}; } }
    }
}

struct RouteArgs { const bf16_t* x1; const float* g2; const float *wgrp, *bgrp, *wexp, *bexp; float* rs; int* bkt; float *wlo, *whi; int* slot_tok; unsigned* blk_hist; };
__device__ __forceinline__ void router_phase(const Frame& F0, const RouteArgs& R) {
    Frame F = F0; F.lane = lane_id_now(); F.tid = F.wave * 64 + F.lane; asm volatile("" : "+s"(F.G), "+s"(F.vcu));
    constexpr int WS = 1032;
    LAS bf16_t* Wh = (LAS bf16_t*)F.lds; LAS bf16_t* Wl = Wh + 20 * WS;
    LAS float* lg = (LAS float*)(F.lds + 20 * WS * 4) + F.wave * 512;
    LAS unsigned* hist = (LAS unsigned*)(F.lds + 20 * WS * 4 + 8 * 2048);
    for (int k = F.tid; k < 1024; k += NTHREADS) {
        const float g = R.g2[k]; const f32x4 wg4 = *(const f32x4*)(R.wgrp + k * 4);
        f32x4 we[4];
#pragma unroll
        for (int q = 0; q < 4; ++q) we[q] = *(const f32x4*)(R.wexp + k * 16 + 4 * q);
#pragma unroll
        for (int n = 0; n < 20; ++n) { const float v = g * (n < 4 ? wg4[n] : we[(n - 4) >> 2][(n - 4) & 3]);
            const unsigned hi = cvt_pk_bf16(v, 0.f) & 0xffffu; const unsigned lo = cvt_pk_bf16(v - bf_lo(hi), 0.f) & 0xffffu;
            Wh[n * WS + k] = (bf16_t)hi; Wl[n * WS + k] = (bf16_t)lo; } }
    if (F.tid < 32) hist[F.tid] = 0u;
    { const int gt = F.vcu * NTHREADS + F.tid, NGT = F.G * NTHREADS; for (int idx = gt; idx < MPAD_MAX; idx += NGT) R.slot_tok[idx] = -1; }
    __syncthreads();
    const int fr = F.lane & 15, fq = F.lane >> 4;
    const int n1 = (16 + fr) < 20 ? (16 + fr) : fr;
    const LAS bf16_t* bh0 = Wh + fr * WS + 8 * fq; const LAS bf16_t* bl0 = Wl + fr * WS + 8 * fq;
    const LAS bf16_t* bh1 = Wh + n1 * WS + 8 * fq; const LAS bf16_t* bl1 = Wl + n1 * WS + 8 * fq;
    for (int tb = F.vcu; tb < NTOK / 128; tb += F.G) {
        const int tok = tb * 128 + F.wave * 16 + fr;
        const bf16_t* xr = R.x1 + (size_t)tok * D + 8 * fq;
        f32x4 acc0 = (f32x4){0.f, 0.f, 0.f, 0.f}, acc1 = acc0; float ss = 0.f;
#pragma unroll 1
        for (int k16 = 0; k16 < 2; ++k16) {
            union { u32x4 u; bf16x8 v; } xa[16];
#pragma unroll
            for (int q = 0; q < 16; ++q) xa[q].u = *(const u32x4*)(xr + (k16 * 16 + q) * 32);
#pragma unroll
            for (int q = 0; q < 16; ++q) { const int ks = k16 * 16 + q; f32x4 a, c; unpack8(xa[q].u, a, c);
                ss += (a[0] * a[0] + a[1] * a[1]) + (a[2] * a[2] + a[3] * a[3]) + (c[0] * c[0] + c[1] * c[1]) + (c[2] * c[2] + c[3] * c[3]);
                const bf16x8 wh0 = *(const LAS bf16x8*)(bh0 + ks * 32), wl0 = *(const LAS bf16x8*)(bl0 + ks * 32), wh1 = *(const LAS bf16x8*)(bh1 + ks * 32), wl1 = *(const LAS bf16x8*)(bl1 + ks * 32);
                acc0 = __builtin_amdgcn_mfma_f32_16x16x32_bf16(xa[q].v, wh0, acc0, 0, 0, 0); acc0 = __builtin_amdgcn_mfma_f32_16x16x32_bf16(xa[q].v, wl0, acc0, 0, 0, 0);
                acc1 = __builtin_amdgcn_mfma_f32_16x16x32_bf16(xa[q].v, wh1, acc1, 0, 0, 0); acc1 = __builtin_amdgcn_mfma_f32_16x16x32_bf16(xa[q].v, wl1, acc1, 0, 0, 0); }
        }
        ss += xor16_f(ss); ss = sum_xor32_f(ss);
        const float rs = 1.0f / sqrtf(ss * (1.0f / D) + EPS);
#pragma unroll
        for (int r = 0; r < 4; ++r) { lg[(4 * fq + r) * 32 + fr] = acc0[r]; lg[(4 * fq + r) * 32 + 16 + fr] = acc1[r]; }
        LDS_WAIT(); asm volatile("" ::: "memory");
        if (F.lane < 16) {
            const LAS float* lp = lg + fr * 32;
            float gl[4]; int gi = 0;
#pragma unroll
            for (int k = 0; k < 4; ++k) gl[k] = lp[k] * rs + R.bgrp[k];
            float gm = gl[0];
#pragma unroll
            for (int k = 1; k < 4; ++k) if (gl[k] > gm) { gm = gl[k]; gi = k; }
            float den = 0.f;
#pragma unroll
            for (int k = 0; k < 4; ++k) den += expf(gl[k] - gm);
            const float gwt = 1.0f / den;
            float el[4];
#pragma unroll
            for (int k = 0; k < 4; ++k) el[k] = lp[4 + gi * 4 + k] * rs + R.bexp[gi * 4 + k];
            int i1 = 0; float v1 = el[0];
#pragma unroll
            for (int k = 1; k < 4; ++k) if (el[k] > v1) { v1 = el[k]; i1 = k; }
            int i2 = -1; float v2 = 0.f;
#pragma unroll
            for (int k = 0; k < 4; ++k) if (k != i1 && (i2 < 0 || el[k] > v2)) { v2 = el[k]; i2 = k; }
            const float e2 = expf(v2 - v1), tw1 = gwt / (1.0f + e2), tw2 = gwt * e2 / (1.0f + e2);
            const int lo_ = i1 < i2 ? i1 : i2, hi_ = i1 < i2 ? i2 : i1;
            const int pr = lo_ == 0 ? hi_ - 1 : (lo_ == 1 ? hi_ + 1 : 5);
            const int bucket = gi * 6 + pr;
            R.rs[tok] = rs; R.bkt[tok] = bucket; R.wlo[tok] = i1 < i2 ? tw1 : tw2; R.whi[tok] = i1 < i2 ? tw2 : tw1;
            __hip_atomic_fetch_add(&hist[bucket], 1u, __ATOMIC_RELAXED, __HIP_MEMORY_SCOPE_WORKGROUP);
        }
        LDS_WAIT(); asm volatile("" ::: "memory");
        __syncthreads();
        if (F.tid < 32) { R.blk_hist[tb * 32 + F.tid] = hist[F.tid]; hist[F.tid] = 0u; }
        __syncthreads();
    }
}
struct SlotArgs { const bf16_t* xb; const float* rs; const int* bkt; const float *wlo, *whi; int* slot_tok; float* slot_w; bf16_t* h2s; const unsigned* blk_hist; unsigned* ntiles; unsigned* tile_bucket; };
__device__ __forceinline__ void slot_phase(const Frame& F0, const SlotArgs& S) {
    Frame F = F0; F.lane = lane_id_now(); F.tid = F.wave * 64 + F.lane; asm volatile("" : "+s"(F.G), "+s"(F.vcu));
    LAS int* offs = (LAS int*)F.lds;
    LAS unsigned* lcnt = (LAS unsigned*)(F.lds + 128);
    LAS unsigned* base = (LAS unsigned*)(F.lds + 256);
    LAS unsigned* part = (LAS unsigned*)(F.lds + 512);
    if (F.tid < 16 * NBUCKET) { const int b = F.tid % NBUCKET, seg = F.tid / NBUCKET; unsigned a = 0;
#pragma unroll
        for (int i = 0; i < 16; ++i) a += S.blk_hist[(seg * 16 + i) * 32 + b];
        part[seg * NBUCKET + b] = a; }
    __syncthreads();
    if (F.tid < NBUCKET) { unsigned c = 0;
#pragma unroll
        for (int sg = 0; sg < 16; ++sg) c += part[sg * NBUCKET + F.tid];
        lcnt[F.tid] = c; }
    __syncthreads();
    if (F.tid == 0) { int off = 0;
#pragma unroll
        for (int b = 0; b < NBUCKET; ++b) { offs[b] = off; off += ((int)lcnt[b] + 255) & ~255; }
        offs[NBUCKET] = off; }
    __syncthreads();
    const int nT = offs[NBUCKET] >> 8;
    if (blockIdx.x == 0) {
        if (F.tid == 0) __hip_atomic_store(S.ntiles, (unsigned)nT, __ATOMIC_RELAXED, __HIP_MEMORY_SCOPE_AGENT);
        if (F.tid < nT) { int tb = 0; for (int b = 0; b < NBUCKET; ++b) if (F.tid * 256 >= offs[b] && F.tid * 256 < offs[b + 1]) tb = b;
            __hip_atomic_store(S.tile_bucket + F.tid, (unsigned)tb, __ATOMIC_RELAXED, __HIP_MEMORY_SCOPE_AGENT); }
    }
    for (int tb = F.vcu; tb < NTOK / 128; tb += F.G) {
        if (F.tid < NBUCKET) { lcnt[F.tid] = 0u; unsigned a = 0; const int sg = tb >> 4;
#pragma unroll
            for (int q = 0; q < 16; ++q) { const unsigned v = part[q * NBUCKET + F.tid]; a += (q < sg) ? v : 0u; }
#pragma unroll
            for (int i = 0; i < 16; ++i) { const unsigned v = S.blk_hist[(sg * 16 + i) * 32 + F.tid]; a += (i < (tb & 15)) ? v : 0u; }
            base[F.tid] = a; }
        __syncthreads();
        const int tokl = tb * 128 + F.wave * 16 + (F.lane & 15);
        int bk = 0; unsigned rank = 0;
        if (F.lane < 16) { bk = S.bkt[tokl]; rank = __hip_atomic_fetch_add(&lcnt[bk], 1u, __ATOMIC_RELAXED, __HIP_MEMORY_SCOPE_WORKGROUP); }
        int slot = 0;
        if (F.lane < 16) { slot = offs[bk] + (int)base[bk] + (int)rank; S.slot_tok[slot] = tokl; *(f32x4*)(S.slot_w + slot * 4) = (f32x4){S.wlo[tokl], S.whi[tokl], S.rs[tokl], 0.f}; }
        const u32x4* src = (const u32x4*)(S.xb + (size_t)(tb * 128 + F.wave * 16) * D) + F.lane;
        u32x4 ra[16], rb[16];
#pragma unroll
        for (int i = 0; i < 16; ++i) { ra[i] = src[i * 128]; rb[i] = src[i * 128 + 64]; }
#pragma unroll
        for (int i = 0; i < 16; ++i) { const int si = __builtin_amdgcn_readlane(slot, i); u32x4* dst = (u32x4*)(S.h2s + (size_t)si * D) + F.lane; dst[0] = ra[i]; dst[64] = rb[i]; }
        __syncthreads();
    }
}

constexpr int N_PHASES = 1 + 10 * DEPTH;
#ifndef PH_MASK
#define PH_MASK 0x7ff
#endif
#define PHON(k) (((PH_MASK) >> (k)) & 1)
__global__ void __launch_bounds__(NTHREADS, 2) fwd(Args args) {
    extern __shared__ __attribute__((aligned(16))) unsigned char lds[];
    Frame F;
    F.lds = (LAS unsigned char*)lds; F.ws = args.ws; F.ctl = (unsigned*)(args.ws + WS_CTL);
    F.wave = __builtin_amdgcn_readfirstlane((int)threadIdx.x >> 6); F.lane = 0; F.tid = 0;
    F.G = gridDim.x; { const int bx = blockIdx.x; F.vcu = (F.G % 8 == 0) ? (bx % 8) * (F.G / 8) + bx / 8 : bx; }
    volatile LAS unsigned* lctl = (volatile LAS unsigned*)(F.lds + LDSCTL_OFF);
    if (threadIdx.x < 64) lctl[threadIdx.x] = 0u;
    __syncthreads();
    const int lo = args.ph_lo, hi = args.ph_hi;
    XcdBarrier bar; bar.bar = F.ctl + CW_BAR; bar.x = 0; bar.st = lctl; bar.wave = F.wave;
    if (hi - lo > 1) bar = xcd_barrier_post(F.ctl + CW_BAR, lctl);
#define IN(k) (lo <= (k) && (k) < hi)
#define SEAM(k) do { if (IN(k) && IN((k) + 1)) xcd_barrier(bar); } while (0)
    unsigned char* ws = args.ws;
    const float* x0 = (const float*)args.in[I_X];
    bf16_t* Hb = (bf16_t*)(ws + WS_HM); bf16_t* Pb = (bf16_t*)(ws + WS_BIG); bf16_t* Gb = (bf16_t*)(ws + WS_BIG); bf16_t* Mg = (bf16_t*)(ws + BIG_MG);
    bf16_t* Ys = (bf16_t*)(ws + WS_YS); bf16_t* X1 = (bf16_t*)(ws + BIG_X1); bf16_t* X2b = (bf16_t*)args.out;     bf16_t* H2s = (bf16_t*)(ws + BIG_H2S); bf16_t* Hid = (bf16_t*)(ws + BIG_HID);
    float* aux_rs = (float*)(ws + AUX_RS); int* aux_bkt = (int*)(ws + AUX_BKT); float* aux_wlo = (float*)(ws + AUX_WLO); float* aux_whi = (float*)(ws + AUX_WHI);
    int* slot_tok = (int*)(ws + AUX_STOK); float* slot_w = (float*)(ws + AUX_SW); unsigned* tile_bucket = (unsigned*)(ws + AUX_TB); unsigned* blk_hist = (unsigned*)(ws + AUX_BH);

    if (PHON(0) && IN(0)) { p0_weights(F, args); norm_rows(F, x0, (const float*)args.in[I_N1G], Hb); }
    SEAM(0);
    for (int l = 0; l < DEPTH; ++l) {
        const int pb = 1 + 10 * l;
        unsigned char* wl = ws + WS_W + (size_t)l * W_LAYER;
        unsigned* ntiles = F.ctl + CW_CNT + 64 * l + 60;
        if (PHON(1) && IN(pb + 0) && l > 0) norm_rows_bf16(F, X2b, (const float*)args.in[I_N1G] + (size_t)l * D, Hb);
        if (l > 0) SEAM(pb + 0);
        if (PHON(2) && IN(pb + 1)) {
            PlainOrder S{(const char*)Hb, (const char*)(wl + W_IN), 128, 9, F.G, (int)blockIdx.x, (size_t)256 * D * 2, (size_t)256 * D * 2};
            EpiInProj E{Pb, (const float*)(ws + WS_ROPE), (const float*)args.in[I_QNG] + l * 64, (const float*)args.in[I_KNG] + l * 64};
            pg8::gemm_phase<EpiInProj, PlainOrder>(F.lds, F.wave, D, D, D, S, E);
        }
        SEAM(pb + 1);
        if (PHON(3) && IN(pb + 2)) {
            MixArgs A{Pb, Ys, (const bf16_t*)(ws + WS_SGU) + (size_t)l * 4 * 128 * 128, (const float*)args.in[I_SLNG] + l * 256, (const float*)args.in[I_SLNB] + l * 256, (const float*)args.in[I_SGUW] + (size_t)l * 4 * 128 * 128, (const float*)args.in[I_SGUB] + l * 4 * 128,
                      (const float*)args.in[I_SINK] + l * 4, (const float*)args.in[I_C3W] + l * 3 * 256, (const float*)args.in[I_C31W] + l * 31 * 256, (const float*)args.in[I_C31B] + l * 256,
                      (const float*)args.in[I_CNG] + l * 256, (const float*)args.in[I_CNB] + l * 256};
            mixer_phase(F, A);
        }
        SEAM(pb + 2);
        if (PHON(4) && IN(pb + 3)) {
            GateMergeOrder S{(const char*)Hb, (const char*)Ys, (const char*)(wl + W_GATE), (const char*)(wl + W_BR), F.G, (int)blockIdx.x};
            EpiGateMerge E{(bf16_t*)(ws + BIG_GS) + (size_t)blockIdx.x * 65536, (bf16_t*)(ws + BIG_MS) + (size_t)blockIdx.x * 65536, Mg, (const float*)args.in[I_BGATE] + (size_t)l * 4096};
            for (int r_ = 0; r_ < 1; ++r_) pg8::gemm_phase<EpiGateMerge, GateMergeOrder>(F.lds, F.wave, D, D, D, S, E);
        }
        SEAM(pb + 3);
        if (PHON(6) && IN(pb + 5)) {
            PlainOrder S{(const char*)Mg, (const char*)(wl + W_O), 128, 4, F.G, (int)blockIdx.x, (size_t)256 * D * 2, (size_t)256 * D * 2};
            EpiWo E{x0, l == 0 ? (const bf16_t*)nullptr : X2b, X1};
            pg8::gemm_phase<EpiWo, PlainOrder>(F.lds, F.wave, D, D, D, S, E);
        }
        SEAM(pb + 5);
        if (PHON(7) && IN(pb + 6)) {
            RouteArgs R{X1, (const float*)args.in[I_N2G] + (size_t)l * D, (const float*)args.in[I_WGRP] + (size_t)l * D * 4, (const float*)args.in[I_BGRP] + l * 4,
                        (const float*)args.in[I_WEXP] + (size_t)l * D * 16, (const float*)args.in[I_BEXP] + l * 16, aux_rs, aux_bkt, aux_wlo, aux_whi, slot_tok, blk_hist};
            router_phase(F, R);
        }
        SEAM(pb + 6);
        if (PHON(8) && IN(pb + 7)) {
            SlotArgs S{X1, aux_rs, aux_bkt, aux_wlo, aux_whi, slot_tok, slot_w, H2s, blk_hist, ntiles, tile_bucket};
            slot_phase(F, S);
        }
        SEAM(pb + 7);
        if (PHON(9) && IN(pb + 8)) {
            const int nT = __builtin_amdgcn_readfirstlane((int)xb_ld(ntiles));
            MoeUpOrder S{(const char*)H2s, (const char*)(wl + W_GU), tile_bucket, nT, F.G, F.vcu};
            EpiMoeUp E{Hid, slot_w};
            pg8::gemm_phase<EpiMoeUp, MoeUpOrder>(F.lds, F.wave, D, D, D, S, E);
        }
        SEAM(pb + 8);
        if (PHON(10) && IN(pb + 9)) {
            const int nT = __builtin_amdgcn_readfirstlane((int)xb_ld(ntiles));
            MoeDownOrder S{(const char*)Hid, (const char*)(wl + W_DN), tile_bucket, nT, F.G, F.vcu};
            EpiMoeDown E{slot_tok, X1, args.out, l + 1 < DEPTH ? X2b : (bf16_t*)nullptr};
            pg8::gemm_phase<EpiMoeDown, MoeDownOrder>(F.lds, F.wave, 512, 512, 256, S, E);
        }
        if (l + 1 < DEPTH) SEAM(pb + 9);
    }
#undef IN
#undef SEAM
}

extern "C" void kernel_launch(void* const* d_in, const int* in_sizes, int n_in, void* d_out, int out_size, void* d_ws, size_t ws_size, hipStream_t stream) {
    static int grid = 0;
    if (grid == 0) {
        if (n_in != N_IN || out_size != NTOK * D || ws_size < WS_END) { fprintf(stderr, "kernel_launch: unexpected shapes (n_in %d, out %d, ws %zu); nothing launched\n", n_in, out_size, ws_size); grid = -1; return; }
        int dev = 0, cus = 0, per_cu = 0;
        if (hipGetDevice(&dev) != hipSuccess || hipDeviceGetAttribute(&cus, hipDeviceAttributeMultiprocessorCount, dev) != hipSuccess) { grid = -1; return; }
        if (hipFuncSetAttribute((const void*)fwd, hipFuncAttributeMaxDynamicSharedMemorySize, LDS_BYTES) != hipSuccess) { fprintf(stderr, "kernel_launch: hipFuncSetAttribute failed\n"); grid = -1; return; }
        if (hipOccupancyMaxActiveBlocksPerMultiprocessor(&per_cu, (const void*)fwd, NTHREADS, LDS_BYTES) != hipSuccess || per_cu < 1)
            fprintf(stderr, "kernel_launch: note: occupancy query reports %d workgroups per CU\n", per_cu);
        (void)hipGetLastError();
        grid = cus;
    }
    if (grid < 0) return;
    (void)hipMemsetAsync((char*)d_ws + WS_CTL, 0, CTL_ZERO_BYTES, stream);
    Args a{};
    for (int i = 0; i < N_IN; ++i) a.in[i] = d_in[i];
    a.out = (float*)d_out; a.ws = (unsigned char*)d_ws;
#if MK_PER_PHASE
    for (int p = 0; p < N_PHASES; ++p) { if (p == 1) continue; a.ph_lo = p; a.ph_hi = p + 1; hipLaunchKernelGGL(fwd, dim3(grid), dim3(NTHREADS), LDS_BYTES, stream, a); }
#else
    a.ph_lo = 0; a.ph_hi = N_PHASES;
    hipLaunchKernelGGL(fwd, dim3(grid), dim3(NTHREADS), LDS_BYTES, stream, a);
#endif
}
```
